# Optimizing an MI355X kernel written in HIP

```python
import jax
import jax.numpy as jnp
from jax import lax
import numpy as np

D_MODEL = 1024
BATCH = 4
SEQ = 8192
DEPTH = 2

GRID_W = 64
CTX_LEN = 256
N_EVEN = (DEPTH + 1) // 2
N_ODD = DEPTH // 2
NORM_EPS = 1e-6

RW_HEAD = 64
RW_DIM = D_MODEL // 2
RW_HEADS = RW_DIM // RW_HEAD
RW_W_LORA = 64
RW_A_LORA = 64
RW_G_LORA = 128
RW_COLS = 3 * RW_DIM + RW_W_LORA + RW_A_LORA + RW_G_LORA
RW_GN_EPS = 64e-5

NA_HEAD = 64
NA_DIM = D_MODEL - RW_DIM
NA_HEADS = NA_DIM // NA_HEAD
NA_ROWS = 8
NA_COLS = 16
NA_SCALE = NA_HEAD ** -0.5
EVEN_COLS = RW_COLS + 3 * NA_DIM

HG_KEY = 128
HG_HEADS = D_MODEL // HG_KEY
HG_KDIM = HG_HEADS * HG_KEY
HG_VAL = D_MODEL // HG_HEADS
HG_VDIM = HG_HEADS * HG_VAL
HG_CHUNK = 64
ODD_COLS = 3 * HG_KDIM + 2 * HG_VDIM

MLP_HIDDEN = 4 * D_MODEL

kernel_name = "hybrid_rwkv7_natten_hgrn2_prefix_dit"


def rmsnorm(x, g, eps=NORM_EPS):
    xf = x.astype(jnp.float32)
    y = xf * lax.rsqrt(jnp.mean(xf * xf, axis=-1, keepdims=True) + eps)
    return (y * g.astype(jnp.float32)).astype(x.dtype)


def modulate(h, shift, scale):
    return h * (1 + scale) + shift


def sq_relu_mlp(h, w1, w2):
    return jnp.square(jax.nn.relu(h @ w1)) @ w2


def bidir_token_shift(p, mu_prev, mu_next):
    zero = jnp.zeros_like(p[:, :1])
    prev = jnp.concatenate([zero, p[:, :-1]], axis=1)
    nxt = jnp.concatenate([p[:, 1:], zero], axis=1)
    return p + (prev - p) * mu_prev + (nxt - p) * mu_next


def _scan_order(z):
    z = jnp.stack([z[0], jnp.flip(z[1], axis=1)])
    return jnp.moveaxis(z, 2, 0)


def _rwkv7_step(S, inp):
    r, w, k, v, kk, a = inp
    s_kk = jnp.einsum('dbhvk,dbhk->dbhv', S, kk)
    S = S * w[..., None, :] - s_kk[..., None] * (kk * a)[..., None, :] + v[..., None] * k[..., None, :]
    return S, jnp.einsum('dbhvk,dbhk->dbhv', S, r)


def head_group_norm(o, g, b):
    of = o.astype(jnp.float32)
    mu = jnp.mean(of, axis=-1, keepdims=True)
    var = jnp.mean(jnp.square(of - mu), axis=-1, keepdims=True)
    y = (of - mu) * lax.rsqrt(var + RW_GN_EPS)
    B, T = o.shape[:2]
    return y.reshape(B, T, -1) * g + b


def rwkv7_mix(p, S0, mu_prev, mu_next, w0, w_up, a0, a_up, g_up, k_k, k_a, r_k, ln_g, ln_b):
    B, T, _ = p.shape
    p = bidir_token_shift(p, mu_prev, mu_next)
    r = p[..., :RW_DIM]
    k = p[..., RW_DIM:2 * RW_DIM]
    v = p[..., 2 * RW_DIM:3 * RW_DIM]
    off = 3 * RW_DIM
    w_lo = p[..., off:off + RW_W_LORA]
    a_lo = p[..., off + RW_W_LORA:off + RW_W_LORA + RW_A_LORA]
    g_lo = p[..., off + RW_W_LORA + RW_A_LORA:]
    w_log = -jax.nn.softplus(-(w0[:, None, None, :] + jnp.einsum('btl,dlc->dbtc', jnp.tanh(w_lo), w_up))) - 0.5
    decay = jnp.exp(-jnp.exp(w_log.astype(jnp.float32)))
    a = jax.nn.sigmoid(a0[:, None, None, :] + jnp.einsum('btl,dlc->dbtc', a_lo, a_up))
    g = jax.nn.sigmoid(g_lo) @ g_up
    heads = lambda z: z.reshape(z.shape[:-1] + (RW_HEADS, RW_HEAD))
    both = lambda z: jnp.stack([z, z])
    kk = heads(k * k_k)
    kk = kk / jnp.maximum(jnp.linalg.norm(kk, axis=-1, keepdims=True), 1e-12)
    k_d = heads(k[None] * (1 + (a - 1) * k_a))
    r_h, v_h = heads(r), heads(v)
    xs = (_scan_order(both(r_h)), _scan_order(heads(decay)), _scan_order(k_d),
          _scan_order(both(v_h)), _scan_order(both(kk)), _scan_order(heads(a)))
    S_fin, o = lax.scan(_rwkv7_step, S0, xs)
    o = jnp.moveaxis(o[:, 0] + jnp.flip(o[:, 1], axis=0), 0, 1)
    o = head_group_norm(o, ln_g, ln_b)
    bonus = jnp.sum(r_h[None] * k_d * r_k, axis=(0, -1))[..., None] * v_h
    out = (o + bonus.reshape(B, T, RW_DIM)) * g
    return out.astype(p.dtype), S_fin


def neighbourhood_attention(q, k, v, k_ctx, v_ctx, rpb):
    B, T, H, dh = q.shape
    rows = T // GRID_W
    kr = min(NA_ROWS, rows)
    q_g = q.reshape(B, rows, GRID_W, H, dh).transpose(1, 0, 3, 2, 4)
    k_g = k.reshape(B, rows, GRID_W, H, dh).transpose(0, 3, 1, 2, 4)
    v_g = v.reshape(B, rows, GRID_W, H, dh).transpose(0, 3, 1, 2, 4)
    kc = k_ctx.transpose(0, 2, 1, 3)
    vc = v_ctx.transpose(0, 2, 1, 3)
    cols = jnp.arange(GRID_W)
    col_start = jnp.clip(cols - NA_COLS // 2, 0, GRID_W - NA_COLS)
    col_idx = col_start[:, None] + jnp.arange(NA_COLS)
    col_rel = col_idx - cols[:, None] + NA_COLS - 1
    n_win = kr * NA_COLS

    def one_row(args):
        r, q_r = args
        r0 = jnp.clip(r - kr // 2, 0, rows - kr)
        row_rel = r0 + jnp.arange(kr) - r + NA_ROWS - 1
        bias = rpb[:, row_rel[:, None, None], col_rel[None, :, :]]
        k_win = lax.dynamic_slice_in_dim(k_g, r0, kr, axis=2)[:, :, :, col_idx]
        v_win = lax.dynamic_slice_in_dim(v_g, r0, kr, axis=2)[:, :, :, col_idx]
        s_win = jnp.einsum('bhqd,bhrqcd->bhqrc', q_r, k_win) * NA_SCALE + bias.transpose(0, 2, 1, 3)[None]
        s_ctx = jnp.einsum('bhqd,bhkd->bhqk', q_r, kc) * NA_SCALE
        s = jnp.concatenate([s_win.reshape(B, H, GRID_W, n_win), s_ctx], axis=-1).astype(jnp.float32)
        pr = jax.nn.softmax(s, axis=-1).astype(v.dtype)
        p_win = pr[..., :n_win].reshape(B, H, GRID_W, kr, NA_COLS)
        return (jnp.einsum('bhqrc,bhrqcd->bhqd', p_win, v_win)
                + jnp.einsum('bhqk,bhkd->bhqd', pr[..., n_win:], vc))

    o = lax.map(one_row, (jnp.arange(rows), q_g))
    return o.transpose(1, 0, 3, 2, 4).reshape(B, T, H * dh)


def context_attention(q, k, v):
    B, L, H, dh = q.shape
    s = jnp.einsum('bqhd,bkhd->bhqk', q, k).astype(jnp.float32) * NA_SCALE
    pr = jax.nn.softmax(s, axis=-1).astype(v.dtype)
    return jnp.einsum('bhqk,bkhd->bqhd', pr, v).reshape(B, L, H * dh)


def hgrn2_inputs(p, lb):
    B, T, _ = p.shape
    q = jax.nn.silu(p[..., :HG_KDIM])
    f = p[..., HG_KDIM:3 * HG_KDIM].reshape(B, T, 2, HG_KDIM).astype(jnp.float32)
    i = p[..., 3 * HG_KDIM:3 * HG_KDIM + HG_VDIM]
    gate = p[..., 3 * HG_KDIM + HG_VDIM:]
    forget = lb + (1 - lb) * jax.nn.sigmoid(f)
    log_f = jnp.log(forget)
    k = 1 - forget
    bh = lambda z, d: z.reshape(B, T, HG_HEADS, d).transpose(0, 2, 1, 3)
    dirs = lambda zf, zb: jnp.stack([zf, jnp.flip(zb, axis=2)])
    qh, ih = bh(q, HG_KEY), bh(i, HG_VAL)
    return (dirs(qh, qh), dirs(bh(k[:, :, 0], HG_KEY), bh(k[:, :, 1], HG_KEY)), dirs(ih, ih),
            dirs(bh(log_f[:, :, 0], HG_KEY), bh(log_f[:, :, 1], HG_KEY)), gate)


def _hgrn2_chunk_step(S, inp):
    qc, kc, vc, gc = inp
    b = jnp.cumsum(gc, axis=-2)
    inter = jnp.einsum('dbhck,dbhkv->dbhcv', qc * jnp.exp(b), S)
    lower_tri = jnp.tril(jnp.ones((HG_CHUNK, HG_CHUNK), dtype=bool))[:, :, None]
    dec = jnp.exp(jnp.where(lower_tri, b[..., :, None, :] - b[..., None, :, :], -jnp.inf))
    att = jnp.einsum('dbhtk,dbhsk,dbhtsk->dbhts', qc, kc, dec)
    o = inter + jnp.einsum('dbhts,dbhsv->dbhtv', att, vc)
    b_last = b[..., -1:, :]
    S = jnp.exp(b_last[..., 0, :])[..., None] * S + jnp.einsum('dbhsk,dbhsv->dbhkv', kc * jnp.exp(b_last - b), vc)
    return S, o


def hgrn2_chunk_scan(S0, q, k, v, g):
    T = q.shape[3]
    nc = T // HG_CHUNK
    chunks = lambda z: jnp.moveaxis(z.reshape(z.shape[:3] + (nc, HG_CHUNK, z.shape[-1])), 3, 0)
    S_fin, o = lax.scan(_hgrn2_chunk_step, S0, (chunks(q), chunks(k), chunks(v), chunks(g)))
    o = jnp.moveaxis(o, 0, 3)
    return o.reshape(o.shape[:3] + (T, o.shape[-1])), S_fin


def hgrn2_final_state(k, v, g):
    b = jnp.cumsum(g, axis=-2)
    return jnp.einsum('dbhtk,dbhtv->dbhkv', k * jnp.exp(b[..., -1:, :] - b), v)


def hgrn2_readout(o, gate, norm_g):
    o = o[0] + jnp.flip(o[1], axis=2)
    B, H, T, V = o.shape
    o = o.transpose(0, 2, 1, 3).reshape(B, T, H * V)
    return (rmsnorm(o, norm_g) * jax.nn.silu(gate)).astype(gate.dtype)


def even_mixer(a_lat, a_ctx, last, w_in, w_out, mu_prev, mu_next, w0, w_up, a0, a_up, g_up,
               k_k, k_a, r_k, ln_g, ln_b, rpb):
    B = a_lat.shape[0]
    p_lat = a_lat @ w_in
    p_ctx = a_ctx @ w_in
    rw = (mu_prev, mu_next, w0, w_up, a0, a_up, g_up, k_k, k_a, r_k, ln_g, ln_b)
    S0 = jnp.zeros((2, B, RW_HEADS, RW_HEAD, RW_HEAD), jnp.float32)
    rw_ctx, S_ctx = rwkv7_mix(p_ctx[..., :RW_COLS], S0, *rw)
    rw_lat, _ = rwkv7_mix(p_lat[..., :RW_COLS], S_ctx, *rw)

    def na_heads(p):
        z = p[..., RW_COLS:]
        sh = z.shape[:2] + (NA_HEADS, NA_HEAD)
        return (z[..., :NA_DIM].reshape(sh), z[..., NA_DIM:2 * NA_DIM].reshape(sh),
                z[..., 2 * NA_DIM:].reshape(sh))

    qc, kc, vc = na_heads(p_ctx)
    ql, kl, vl = na_heads(p_lat)
    na_lat = neighbourhood_attention(ql, kl, vl, kc, vc, rpb)
    y_lat = jnp.concatenate([rw_lat, na_lat], axis=-1) @ w_out
    if last:
        return y_lat, None
    na_ctx = context_attention(qc, kc, vc)
    y_ctx = jnp.concatenate([rw_ctx, na_ctx], axis=-1) @ w_out
    return y_lat, y_ctx


def odd_mixer(a_lat, a_ctx, last, w_in, w_out, lb, norm_g):
    ql, kl, vl, gl, gate_l = hgrn2_inputs(a_lat @ w_in, lb)
    qc, kc, vc, gc, gate_c = hgrn2_inputs(a_ctx @ w_in, lb)
    if last:
        S_ctx = hgrn2_final_state(kc, vc, gc)
    else:
        S0 = jnp.zeros(kc.shape[:3] + (HG_KEY, HG_VAL), jnp.float32)
        o_ctx, S_ctx = hgrn2_chunk_scan(S0, qc, kc, vc, gc)
    o_lat, _ = hgrn2_chunk_scan(S_ctx, ql, kl, vl, gl)
    y_lat = hgrn2_readout(o_lat, gate_l, norm_g) @ w_out
    if last:
        return y_lat, None
    return y_lat, hgrn2_readout(o_ctx, gate_c, norm_g) @ w_out


def setup_inputs(seed: int = 0) -> dict:
    key = jax.random.key(seed)
    ks = iter(jax.random.split(key, 40))
    f32 = jnp.float32
    D = D_MODEL

    def nrm(shape, std):
        return std * jax.random.normal(next(ks), shape, f32)

    def gain(shape, s=0.05):
        return 1.0 + s * jax.random.normal(next(ks), shape, f32)

    return {
        "x": nrm((BATCH, SEQ, D), 1.0),
        "c": nrm((BATCH, D), 1.0),
        "ctx": nrm((BATCH, CTX_LEN, D), 1.0),
        "c_ctx": nrm((D,), 1.0),
        "norm_mix_g": gain((DEPTH, D)),
        "norm_mlp_g": gain((DEPTH, D)),
        "ada_w": nrm((DEPTH, D, 6 * D), 0.5 * D ** -0.5),
        "ada_b": nrm((DEPTH, 6 * D), 0.02),
        "mlp_w1": nrm((DEPTH, D, MLP_HIDDEN), D ** -0.5),
        "mlp_w2": nrm((DEPTH, MLP_HIDDEN, D), MLP_HIDDEN ** -0.5),
        "ev_w_in": nrm((N_EVEN, D, EVEN_COLS), D ** -0.5),
        "ev_w_out": nrm((N_EVEN, RW_DIM + NA_DIM, D), (RW_DIM + NA_DIM) ** -0.5),
        "rw_mu_prev": jax.random.uniform(next(ks), (N_EVEN, RW_COLS), f32, 0.0, 0.5),
        "rw_mu_next": jax.random.uniform(next(ks), (N_EVEN, RW_COLS), f32, 0.0, 0.5),
        "rw_w0": jax.random.uniform(next(ks), (N_EVEN, 2, RW_DIM), f32, -3.0, 1.0),
        "rw_w_up": nrm((N_EVEN, 2, RW_W_LORA, RW_DIM), 0.1),
        "rw_a0": nrm((N_EVEN, 2, RW_DIM), 0.1),
        "rw_a_up": nrm((N_EVEN, 2, RW_A_LORA, RW_DIM), 0.5 * RW_A_LORA ** -0.5),
        "rw_g_up": nrm((N_EVEN, RW_G_LORA, RW_DIM), RW_G_LORA ** -0.5),
        "rw_k_k": 0.85 + nrm((N_EVEN, RW_DIM), 0.05),
        "rw_k_a": gain((N_EVEN, RW_DIM)),
        "rw_r_k": nrm((N_EVEN, RW_HEADS, RW_HEAD), 0.1),
        "rw_ln_g": gain((N_EVEN, RW_DIM)),
        "rw_ln_b": nrm((N_EVEN, RW_DIM), 0.02),
        "na_rpb": nrm((N_EVEN, NA_HEADS, 2 * NA_ROWS - 1, 2 * NA_COLS - 1), 0.1),
        "od_w_in": nrm((N_ODD, D, ODD_COLS), D ** -0.5),
        "od_w_out": nrm((N_ODD, HG_VDIM, D), HG_VDIM ** -0.5),
        "hg_lower": gain((DEPTH, HG_KDIM), 0.1),
        "hg_norm_g": gain((N_ODD, HG_VDIM)),
        "final_norm_g": gain((D,)),
    }


def reference(x, c, ctx, c_ctx, norm_mix_g, norm_mlp_g, ada_w, ada_b, mlp_w1, mlp_w2,
              ev_w_in, ev_w_out, rw_mu_prev, rw_mu_next, rw_w0, rw_w_up, rw_a0, rw_a_up, rw_g_up,
              rw_k_k, rw_k_a, rw_r_k, rw_ln_g, rw_ln_b, na_rpb, od_w_in, od_w_out, hg_lower,
              hg_norm_g, final_norm_g):
    sc = jax.nn.silu(c)
    scc = jax.nn.silu(c_ctx)
    lb_sm = jax.nn.softmax(hg_lower.astype(jnp.float32), axis=0)
    lb_all = jnp.cumsum(lb_sm, axis=0) - lb_sm[0]
    h_lat, h_ctx = x, ctx
    for l in range(DEPTH):
        last = l == DEPTH - 1
        m = sc @ ada_w[l] + ada_b[l]
        mc = scc @ ada_w[l] + ada_b[l]
        sh1, s1, g1, sh2, s2, g2 = jnp.split(m[:, None, :], 6, axis=-1)
        csh1, cs1, cg1, csh2, cs2, cg2 = jnp.split(mc, 6)
        a_lat = modulate(rmsnorm(h_lat, norm_mix_g[l]), sh1, s1)
        a_ctx = modulate(rmsnorm(h_ctx, norm_mix_g[l]), csh1, cs1)
        if l % 2 == 0:
            e = l // 2
            y_lat, y_ctx = even_mixer(a_lat, a_ctx, last, ev_w_in[e], ev_w_out[e], rw_mu_prev[e],
                                      rw_mu_next[e], rw_w0[e], rw_w_up[e], rw_a0[e], rw_a_up[e],
                                      rw_g_up[e], rw_k_k[e], rw_k_a[e], rw_r_k[e], rw_ln_g[e],
                                      rw_ln_b[e], na_rpb[e])
        else:
            o = l // 2
            y_lat, y_ctx = odd_mixer(a_lat, a_ctx, last, od_w_in[o], od_w_out[o], lb_all[l], hg_norm_g[o])
        h_lat = h_lat + g1 * y_lat
        h_lat = h_lat + g2 * sq_relu_mlp(modulate(rmsnorm(h_lat, norm_mlp_g[l]), sh2, s2), mlp_w1[l], mlp_w2[l])
        if not last:
            h_ctx = h_ctx + cg1 * y_ctx
            h_ctx = h_ctx + cg2 * sq_relu_mlp(modulate(rmsnorm(h_ctx, norm_mlp_g[l]), csh2, cs2), mlp_w1[l], mlp_w2[l])
    return rmsnorm(h_lat, final_norm_g)
```

```cpp
#include <hip/hip_runtime.h>
#include <cstdio>
#include <cstdint>
#include <cstring>
namespace pg8 {
#define PG8_LAS __attribute__((address_space(3)))
typedef unsigned short bf16_t;
typedef short bf16x8 __attribute__((ext_vector_type(8)));
typedef float f32x4 __attribute__((ext_vector_type(4)));
typedef unsigned u32x4 __attribute__((ext_vector_type(4)));
constexpr int BM = 256, BK = 64, HALF = 128, HTB = HALF * BK * 2  , STAGE_BYTES = 8 * HTB, NXCD = 8, WGM = 8;

__host__ __device__ __forceinline__ int lds_byte(int r, int c) { const int st = (r >> 4) * 2 + (c >> 5), rr = r & 15, cc = c & 31, ob = rr * 64 + cc * 2; return st * 1024 + (ob ^ (((ob >> 9) & 1) << 5)); }
__host__ __device__ __forceinline__ void stage_rc(int b, int& R, int& C) { const int st = b / 1024, sb = b % 1024, swz = sb ^ (((sb >> 9) & 1) << 5); R = (st >> 1) * 16 + swz / 64; C = (st & 1) * 32 + (swz % 64) / 2; }
__host__ __device__ __forceinline__ int perm32(int rho) { const int n = rho >> 4, i = rho & 15; return 8 * (i >> 2) + 4 * n + (i & 3); }

struct Unit { int pm, pn; };
struct Gemm { const bf16_t* A; const bf16_t* Bt; int M, N, K; };

struct StaticOrder {
    int nM, nN, nwg, G, c;
    __host__ __device__ void init(int M, int N, int G_, int c_) { nM = M / BM; nN = N / BM; nwg = nM * nN; G = G_; c = c_; }
    __host__ __device__ bool next(int i, Unit& u) const {
        const long L = (long)i * G + c; if (L >= nwg) return false;
        int wgid = (int)L; { const int q = nwg / NXCD, r = nwg % NXCD, xcd = wgid % NXCD, off = wgid / NXCD; wgid = (xcd < r ? xcd * (q + 1) : r * (q + 1) + (xcd - r) * q) + off; }
        const int nig = WGM * nN, gid = wgid / nig, fm = gid * WGM, gsz = (nM - fm) < WGM ? (nM - fm) : WGM;
        u.pm = fm + ((wgid % nig) % gsz); u.pn = (wgid % nig) / gsz; return true;
    }
    __device__ __forceinline__ void a_ready(const Unit&) const {}
    __device__ __forceinline__ void done(const Unit&) const {}
};
__device__ __forceinline__ unsigned cvt_pk_bf16(float lo, float hi) { unsigned r; asm volatile("v_cvt_pk_bf16_f32 %0, %1, %2" : "=v"(r) : "v"(lo), "v"(hi)); return r; }
template <class Epi, class Sched, bool ALIGN_EPI = false, bool SP2 = false>
__device__ __forceinline__ void gemm_phase(PG8_LAS unsigned char* lds, const Gemm g, const Sched& S, const Epi& E) {
    const int tid = threadIdx.x, wid = __builtin_amdgcn_readfirstlane(tid >> 6), lane = tid & 63, wr = wid >> 2, wc = wid & 3, fr = lane & 15, fq = lane >> 4;
    const int K = g.K, nt = K / BK;
    unsigned voffA[2], voffB[2];
#pragma unroll
    for (int i = 0; i < 2; ++i) { int R, C; stage_rc(tid * 16 + i * 8192, R, C); const int Rb = Epi::PERM ? ((R & ~31) + perm32(R & 31)) : R;
        voffA[i] = (unsigned)(R * K + C) * 2u; voffB[i] = (unsigned)(Rb * K + C) * 2u; }
    const size_t kstep = (size_t)(BK * 2);
    const size_t hstep = (size_t)HALF * K * 2;
    const size_t tstep = 2 * hstep;
    const unsigned ldsw = (unsigned)wid * 1024u;
    const int aoff = lds_byte(wr * 64 + fr, fq * 8), boff = lds_byte(wc * 32 + fr, fq * 8);
#define PG8_SA(b, h) (((b) * 2 + (h)) * HTB)
#define PG8_SB(b, h) ((4 + (b) * 2 + (h)) * HTB)
#define PG8_STAGE(bufoff, gbase, voff) do { _Pragma("unroll") for (int _i = 0; _i < 2; ++_i) \
        __builtin_amdgcn_global_load_lds((const unsigned*)((const char*)(gbase) + (voff)[_i]), (PG8_LAS unsigned*)(lds + (bufoff) + ldsw + _i * 8192), 16, 0, 0); } while (0)
#define PG8_LDA(dst, b, h) do { _Pragma("unroll") for (int m = 0; m < 4; ++m) _Pragma("unroll") for (int k = 0; k < 2; ++k) dst[m][k] = *(const PG8_LAS bf16x8*)(lds + PG8_SA(b, h) + aoff + m * 2048 + k * 1024); } while (0)
#define PG8_LDB(dst, b, h) do { _Pragma("unroll") for (int n = 0; n < 2; ++n) _Pragma("unroll") for (int k = 0; k < 2; ++k) dst[n][k] = *(const PG8_LAS bf16x8*)(lds + PG8_SB(b, h) + boff + n * 2048 + k * 1024); } while (0)
#define PG8_MMA(ai, bj, At, Bt) do { __builtin_amdgcn_s_setprio(1); _Pragma("unroll") for (int m = 0; m < 4; ++m) _Pragma("unroll") for (int n = 0; n < 2; ++n) _Pragma("unroll") for (int k = 0; k < 2; ++k) \
        acc[ai][bj][m][n] = __builtin_amdgcn_mfma_f32_16x16x32_bf16(Bt[n][k], At[m][k], acc[ai][bj][m][n], 0, 0, 0); __builtin_amdgcn_s_setprio(0); } while (0)
#define PG8_WAIT_V(n) asm volatile("s_waitcnt vmcnt(" #n ")" ::: "memory")
#define PG8_WAIT_L(n) asm volatile("s_waitcnt lgkmcnt(" #n ")" ::: "memory")
#define PG8_BAR __builtin_amdgcn_s_barrier()
#define PG8_SCHED __builtin_amdgcn_sched_barrier(0)
    Unit cur, nxt; int ui = 0;
    if (!S.next(0, cur)) return;
    f32x4 acc[2][2][4][2];
#pragma unroll
    for (int a = 0; a < 2; ++a)
#pragma unroll
        for (int b = 0; b < 2; ++b)
#pragma unroll
            for (int m = 0; m < 4; ++m)
#pragma unroll
                for (int n = 0; n < 2; ++n) acc[a][b][m][n] = (f32x4){0.f, 0.f, 0.f, 0.f};
    bf16x8 At[4][2], B0[2][2], B1[2][2];
    const char* cA = (const char*)g.A + (size_t)cur.pm * tstep; const char* cB = (const char*)g.Bt + (size_t)cur.pn * tstep;
    S.a_ready(cur);
    if constexpr (SP2) {
        PG8_STAGE(PG8_SB(0, 0), cB, voffB); PG8_STAGE(PG8_SB(0, 1), cB + hstep, voffB); PG8_STAGE(PG8_SA(0, 0), cA, voffA); PG8_STAGE(PG8_SA(0, 1), cA + hstep, voffA);
        if (wr == 1) PG8_BAR;
        PG8_WAIT_V(2); PG8_BAR;
        PG8_STAGE(PG8_SB(1, 0), cB + kstep, voffB); PG8_STAGE(PG8_SA(1, 0), cA + kstep, voffA); PG8_STAGE(PG8_SB(1, 1), cB + hstep + kstep, voffB);
        PG8_WAIT_V(6); PG8_BAR;
    } else {
        PG8_STAGE(PG8_SB(0, 0), cB, voffB); PG8_STAGE(PG8_SA(0, 0), cA, voffA); PG8_STAGE(PG8_SB(0, 1), cB + hstep, voffB); PG8_STAGE(PG8_SA(0, 1), cA + hstep, voffA);
        if (wr == 1) PG8_BAR;
        PG8_WAIT_V(4); PG8_BAR;
        PG8_STAGE(PG8_SB(1, 0), cB + kstep, voffB); PG8_STAGE(PG8_SA(1, 0), cA + kstep, voffA); PG8_STAGE(PG8_SB(1, 1), cB + hstep + kstep, voffB);
        PG8_WAIT_V(6); PG8_BAR;
    }
    for (;;) {
        const bool has_next = S.next(ui + 1, nxt);
        const char* nA = has_next ? (const char*)g.A + (size_t)nxt.pm * tstep : cA; const char* nB = has_next ? (const char*)g.Bt + (size_t)nxt.pn * tstep : cB;
        for (int t = 0; t < nt; t += 2) {
            const bool last = (t == nt - 2);
            const char* a1 = cA + (size_t)(t + 1) * kstep;
            const char* a2 = last ? nA : cA + (size_t)(t + 2) * kstep; const char* b2 = last ? nB : cB + (size_t)(t + 2) * kstep;
            const char* a3 = a2 + kstep; const char* b3 = b2 + kstep;
            if (last && has_next) S.a_ready(nxt);
            if constexpr (SP2) {
            PG8_LDB(B0, 0, 0); PG8_LDB(B1, 0, 1); PG8_SCHED; PG8_LDA(At, 0, 0); PG8_STAGE(PG8_SA(1, 1), a1 + hstep, voffA);
            PG8_WAIT_V(8); PG8_WAIT_L(0); PG8_BAR; PG8_MMA(0, 0, At, B0); PG8_MMA(0, 1, At, B1); PG8_BAR; PG8_SCHED;
            PG8_LDA(At, 0, 1); PG8_STAGE(PG8_SB(0, 0), b2, voffB); PG8_STAGE(PG8_SB(0, 1), b2 + hstep, voffB); PG8_STAGE(PG8_SA(0, 0), a2, voffA);
            PG8_WAIT_V(8); PG8_WAIT_L(0); PG8_BAR; PG8_MMA(1, 0, At, B0); PG8_MMA(1, 1, At, B1); PG8_BAR; PG8_SCHED;
            PG8_LDB(B0, 1, 0); PG8_LDB(B1, 1, 1); PG8_SCHED; PG8_LDA(At, 1, 0); PG8_STAGE(PG8_SA(0, 1), a2 + hstep, voffA);
            PG8_WAIT_V(8); PG8_WAIT_L(0); PG8_BAR; PG8_MMA(0, 0, At, B0); PG8_MMA(0, 1, At, B1); PG8_BAR; PG8_SCHED;
            PG8_LDA(At, 1, 1); PG8_STAGE(PG8_SB(1, 0), b3, voffB); PG8_STAGE(PG8_SB(1, 1), b3 + hstep, voffB); PG8_STAGE(PG8_SA(1, 0), a3, voffA);
            PG8_WAIT_V(8); PG8_WAIT_L(0); PG8_BAR; PG8_MMA(1, 0, At, B0); PG8_MMA(1, 1, At, B1); PG8_BAR; PG8_SCHED;
            } else {
            PG8_LDB(B0, 0, 0); PG8_SCHED; PG8_LDA(At, 0, 0); PG8_STAGE(PG8_SA(1, 1), a1 + hstep, voffA);
            PG8_WAIT_L(8); PG8_BAR; PG8_WAIT_L(0); PG8_MMA(0, 0, At, B0); PG8_BAR; PG8_SCHED;
            PG8_LDB(B1, 0, 1); PG8_STAGE(PG8_SB(0, 0), b2, voffB);
            PG8_BAR; PG8_WAIT_L(0); PG8_MMA(0, 1, At, B1); PG8_BAR;
            PG8_LDA(At, 0, 1); PG8_STAGE(PG8_SA(0, 0), a2, voffA);
            PG8_BAR; PG8_WAIT_L(0); PG8_MMA(1, 0, At, B0); PG8_BAR; PG8_SCHED;
            PG8_STAGE(PG8_SB(0, 1), b2 + hstep, voffB);
            PG8_WAIT_V(6); PG8_BAR; PG8_MMA(1, 1, At, B1); PG8_BAR;
            PG8_LDB(B0, 1, 0); PG8_SCHED; PG8_LDA(At, 1, 0); PG8_STAGE(PG8_SA(0, 1), a2 + hstep, voffA);
            PG8_WAIT_L(8); PG8_BAR; PG8_WAIT_L(0); PG8_MMA(0, 0, At, B0); PG8_BAR; PG8_SCHED;
            PG8_LDB(B1, 1, 1); PG8_STAGE(PG8_SB(1, 0), b3, voffB);
            PG8_BAR; PG8_WAIT_L(0); PG8_MMA(0, 1, At, B1); PG8_BAR;
            PG8_LDA(At, 1, 1); PG8_STAGE(PG8_SA(1, 0), a3, voffA);
            PG8_BAR; PG8_WAIT_L(0); PG8_MMA(1, 0, At, B0); PG8_BAR; PG8_SCHED;
            PG8_STAGE(PG8_SB(1, 1), b3 + hstep, voffB);
            PG8_WAIT_V(6); PG8_BAR; PG8_MMA(1, 1, At, B1); PG8_BAR;
            }
        }
        if constexpr (ALIGN_EPI) { if (wr == 0) PG8_BAR; }
        if constexpr (!Epi::AFTER_DRAIN) { E(acc, cur, wr, wc, fr, fq); S.done(cur); }
        if (!has_next) break;
#pragma unroll
        for (int a = 0; a < 2; ++a)
#pragma unroll
            for (int b = 0; b < 2; ++b)
#pragma unroll
                for (int m = 0; m < 4; ++m)
#pragma unroll
                    for (int n = 0; n < 2; ++n) acc[a][b][m][n] = (f32x4){0.f, 0.f, 0.f, 0.f};
        cur = nxt; cA = nA; cB = nB; ++ui;
        if constexpr (ALIGN_EPI) { if (wr == 1) PG8_BAR; }
    }
    PG8_WAIT_V(0);
    if constexpr (!ALIGN_EPI) { if (wr == 0) PG8_BAR; }
    PG8_BAR;
    if constexpr (Epi::AFTER_DRAIN) { E.fused(acc, cur, wr, wc, fr, fq, lds, wid, lane); S.done(cur); }
#undef PG8_SA
#undef PG8_SB
#undef PG8_STAGE
#undef PG8_LDA
#undef PG8_LDB
#undef PG8_MMA
#undef PG8_WAIT_V
#undef PG8_WAIT_L
#undef PG8_BAR
#undef PG8_SCHED
}
}

typedef unsigned short bf16_t;
typedef float f32x4 __attribute__((ext_vector_type(4)));
typedef unsigned u32x4 __attribute__((ext_vector_type(4)));
typedef unsigned u32x2 __attribute__((ext_vector_type(2)));
constexpr int DM = 1024, NB = 4, TL = 8192, LC = 256;
constexpr int MLAT = NB * TL, MCTX = NB * LC, MALL = MLAT + MCTX;
constexpr int NIN0 = 3328, NIN1 = 5120, NHID = 4096;
constexpr float NORM_EPS = 1e-6f;

__device__ __forceinline__ float bf2f(bf16_t b) { return __uint_as_float(((unsigned)b) << 16); }
__device__ __forceinline__ bf16_t f2bf(float f) { unsigned u = __float_as_uint(f); u += 0x7fffu + ((u >> 16) & 1u); return (bf16_t)(u >> 16); }
__device__ __forceinline__ unsigned pk2(float lo, float hi) { return (unsigned)f2bf(lo) | ((unsigned)f2bf(hi) << 16); }
__device__ __forceinline__ float sigmoidf_(float x) { return 1.f / (1.f + __expf(-x)); }
__device__ __forceinline__ float siluf_(float x) { return x / (1.f + __expf(-x)); }
__device__ __forceinline__ float wave_sum(float v) {
#pragma unroll
    for (int o = 1; o < 64; o <<= 1) v += __shfl_xor(v, o);
    return v;
}

constexpr size_t WS_CTL  = 0;
constexpr size_t WS_MOD  = 65536;
constexpr size_t WS_LB   = WS_MOD + 2 * 5 * 6144 * 4;
constexpr size_t WS_GS   = WS_LB + 4096;
constexpr size_t WS_SHW0 = WS_GS + 4 * 5 * 1024 * 4;
constexpr size_t WS_SHW1 = WS_SHW0 + 5 * 3328 * 4;
constexpr size_t WS_SHW2 = WS_SHW1 + 5 * 4096 * 4;
constexpr size_t WS_SHW3 = WS_SHW2 + 5 * 5120 * 4;
constexpr size_t WS_SSQ  = WS_SHW3 + 5 * 4096 * 4;
constexpr size_t WS_BC   = WS_SSQ + (size_t)MALL * 64;
constexpr size_t WS_HCTX = WS_BC + (size_t)MALL * 32;
constexpr size_t WS_WT   = WS_HCTX + (size_t)MCTX * DM * 4;
constexpr size_t WT_IN0 = 0, WT_OUT0 = WT_IN0 + (size_t)NIN0 * DM * 2, WT_W10 = WT_OUT0 + (size_t)DM * DM * 2, WT_W20 = WT_W10 + (size_t)NHID * DM * 2,
                 WT_IN1 = WT_W20 + (size_t)NHID * DM * 2, WT_OUT1 = WT_IN1 + (size_t)NIN1 * DM * 2, WT_W11 = WT_OUT1 + (size_t)DM * DM * 2, WT_W21 = WT_W11 + (size_t)NHID * DM * 2,
                 WT_END = WT_W21 + (size_t)NHID * DM * 2;
constexpr size_t WS_BUF0 = WS_WT + WT_END;
constexpr size_t WS_BIG  = WS_BUF0 + (size_t)MALL * DM * 2;
constexpr size_t BIG_HB  = (size_t)MALL * NHID * 2;
constexpr size_t BIG_P0END = (size_t)MALL * NIN0 * 2;
constexpr size_t WS_END  = WS_BIG + (size_t)MALL * NIN1 * 2;

__device__ __forceinline__ void gemv5_item(const float* W, int ldw, int n0, const float* s, float* red, float* out, int ldo, const float* bias) {
    const int tid = threadIdx.x, w = tid >> 6, lane = tid & 63;
    float a0 = 0.f, a1 = 0.f, a2 = 0.f, a3 = 0.f, a4 = 0.f;
    const float* wp = W + (size_t)(w * 128) * ldw + n0 + lane;
#pragma unroll 8
    for (int k = 0; k < 128; ++k) { const float wv = wp[(size_t)k * ldw]; const int kk = w * 128 + k;
        a0 += s[kk] * wv; a1 += s[1024 + kk] * wv; a2 += s[2048 + kk] * wv; a3 += s[3072 + kk] * wv; a4 += s[4096 + kk] * wv; }
    red[(w * 5 + 0) * 64 + lane] = a0; red[(w * 5 + 1) * 64 + lane] = a1; red[(w * 5 + 2) * 64 + lane] = a2; red[(w * 5 + 3) * 64 + lane] = a3; red[(w * 5 + 4) * 64 + lane] = a4;
    __syncthreads();
    if (tid < 320) { const int mb = tid >> 6; float r = bias ? bias[n0 + lane] : 0.f;
#pragma unroll
        for (int ww = 0; ww < 8; ++ww) r += red[(ww * 5 + mb) * 64 + lane];
        out[(size_t)mb * ldo + n0 + lane] = r; }
    __syncthreads();
}

__global__ void __launch_bounds__(512) k_adaln(const float* c, const float* c_ctx, const float* ada_w, const float* ada_b, const float* hg_lower, float* mod, float* lb) {
    __shared__ float s[5 * 1024]; __shared__ float red[8 * 5 * 64];
    const int tid = threadIdx.x;
    for (int i = tid; i < 5 * 1024; i += 512) { const int mb = i >> 10, k = i & 1023; const float x = mb < 4 ? c[mb * 1024 + k] : c_ctx[k]; s[i] = siluf_(x); }
    __syncthreads();
    for (int it = blockIdx.x; it < 2 * 96; it += gridDim.x) { const int l = it / 96, n0 = (it % 96) * 64;
        gemv5_item(ada_w + (size_t)l * 1024 * 6144, 6144, n0, s, red, mod + (size_t)l * 5 * 6144, 6144, ada_b + l * 6144); }
    if (blockIdx.x == 0) for (int k = tid; k < 1024; k += 512) lb[k] = sigmoidf_(hg_lower[1024 + k] - hg_lower[k]);
}

__global__ void k_gs(const float* mod, const float* norm_mix_g, const float* norm_mlp_g, float* gs) {
    const int i = blockIdx.x * blockDim.x + threadIdx.x; if (i >= 4 * 5 * 1024) return;
    const int w = i / 5120, mb = (i / 1024) % 5, k = i & 1023, l = w >> 1, second = w & 1;
    const float g = second ? norm_mlp_g[l * 1024 + k] : norm_mix_g[l * 1024 + k];
    const float sc = mod[(size_t)(l * 5 + mb) * 6144 + (second ? 4 * 1024 : 1024) + k];
    gs[i] = g * (1.f + sc);
}

__global__ void __launch_bounds__(512) k_shw(const float* mod, const float* w_in0, const float* w1, const float* w_in1, float* shw0, float* shw1, float* shw2, float* shw3) {
    __shared__ float s[5 * 1024]; __shared__ float red[8 * 5 * 64];
    const int tid = threadIdx.x;
    int cur = -1;
    for (int it = blockIdx.x; it < 52 + 64 + 80 + 64; it += gridDim.x) {
        int which, n0; const float* W; int ldw; float* out;
        if (it < 52) { which = 0; n0 = it * 64; W = w_in0; ldw = NIN0; out = shw0; }
        else if (it < 116) { which = 1; n0 = (it - 52) * 64; W = w1; ldw = NHID; out = shw1; }
        else if (it < 196) { which = 2; n0 = (it - 116) * 64; W = w_in1; ldw = NIN1; out = shw2; }
        else { which = 3; n0 = (it - 196) * 64; W = w1 + (size_t)1024 * NHID; ldw = NHID; out = shw3; }
        if (which != cur) { __syncthreads(); const int l = which >> 1, off = (which & 1) ? 3 * 1024 : 0;
            for (int i = tid; i < 5 * 1024; i += 512) { const int mb = i >> 10, k = i & 1023; s[i] = mod[(size_t)(l * 5 + mb) * 6144 + off + k]; }
            __syncthreads(); cur = which; }
        gemv5_item(W, ldw, n0, s, red, out, ldw, nullptr);
    }
}

__device__ __forceinline__ void transpose_item(const float* W, int K, int N, bf16_t* WT, float* scr, int item, int lane) {
    const int nblk = N / 32, kb = item / nblk, nb = item % nblk, k0 = 64 * kb, n0 = 32 * nb;
#pragma unroll 8
    for (int i = 0; i < 32; ++i) { const int kk = 2 * i + (lane >> 5); scr[kk * 33 + (lane & 31)] = W[(size_t)(k0 + kk) * N + n0 + (lane & 31)]; }
    __builtin_amdgcn_s_waitcnt(0xc07f); asm volatile("" ::: "memory");
    const int c = lane & 7;
#pragma unroll
    for (int j = 0; j < 4; ++j) { const int n = (lane >> 3) + 8 * j; const float* sp = scr + (8 * c) * 33 + n;
        u32x4 o; o.x = pk2(sp[0 * 33], sp[1 * 33]); o.y = pk2(sp[2 * 33], sp[3 * 33]); o.z = pk2(sp[4 * 33], sp[5 * 33]); o.w = pk2(sp[6 * 33], sp[7 * 33]);
        *(u32x4*)(WT + (size_t)(n0 + n) * K + k0 + 8 * c) = o; }
    __builtin_amdgcn_s_waitcnt(0xc07f); asm volatile("" ::: "memory");
}
struct WtJob { const float* W; int K, N; size_t off; };
__global__ void __launch_bounds__(512) k_wt(const float* w_in0, const float* w_out0, const float* w1, const float* w2, const float* w_in1, const float* w_out1, bf16_t* wt) {
    __shared__ float scr_all[8 * 64 * 33];
    const int tid = threadIdx.x, w = tid >> 6, lane = tid & 63;
    float* scr = scr_all + w * 64 * 33;
    const int gw = blockIdx.x * 8 + w, NGW = gridDim.x * 8;
    const WtJob jobs[8] = { {w_in0, 1024, NIN0, WT_IN0}, {w_out0, 1024, 1024, WT_OUT0}, {w1, 1024, NHID, WT_W10}, {w2, NHID, 1024, WT_W20},
                            {w_in1, 1024, NIN1, WT_IN1}, {w_out1, 1024, 1024, WT_OUT1}, {w1 + (size_t)1024 * NHID, 1024, NHID, WT_W11}, {w2 + (size_t)NHID * 1024, NHID, 1024, WT_W21} };
#pragma unroll
    for (int j = 0; j < 8; ++j) { const int nitems = (jobs[j].K / 64) * (jobs[j].N / 32);
        for (int it = gw; it < nitems; it += NGW) transpose_item(jobs[j].W, jobs[j].K, jobs[j].N, (bf16_t*)((char*)wt + jobs[j].off), scr, it, lane); }
}

__global__ void __launch_bounds__(512) k_norm_in(const float* x, const float* ctx, const float* gs  , bf16_t* xb, float* ssq) {
    const int w = threadIdx.x >> 6, lane = threadIdx.x & 63;
    for (int row = blockIdx.x * 8 + w; row < MALL; row += gridDim.x * 8) {
        const float* xr = row < MLAT ? x + (size_t)row * DM : ctx + (size_t)(row - MLAT) * DM;
        const int mb = row < MLAT ? row >> 13 : 4;
        const f32x4* x4 = (const f32x4*)xr + lane; const f32x4* g4 = (const f32x4*)(gs + mb * 1024) + lane;
        f32x4 v[4]; float s = 0.f;
#pragma unroll
        for (int j = 0; j < 4; ++j) { v[j] = x4[64 * j]; s += (v[j].x * v[j].x + v[j].y * v[j].y) + (v[j].z * v[j].z + v[j].w * v[j].w); }
        s = wave_sum(s);
        u32x2* o = (u32x2*)(xb + (size_t)row * DM) + lane;
#pragma unroll
        for (int j = 0; j < 4; ++j) { const f32x4 g = g4[64 * j]; u32x2 pk; pk.x = pk2(v[j].x * g.x, v[j].y * g.y); pk.y = pk2(v[j].z * g.z, v[j].w * g.w); o[64 * j] = pk; }
        if (lane < 16) ssq[(size_t)row * 16 + lane] = lane == 0 ? s : 0.f;
    }
}

__global__ void __launch_bounds__(512) k_final(float* out, const float* ssq, const float* g) {
    const int w = threadIdx.x >> 6, lane = threadIdx.x & 63;
    for (int row = blockIdx.x * 8 + w; row < MLAT; row += gridDim.x * 8) {
        float s = lane < 16 ? ssq[(size_t)row * 16 + lane] : 0.f; s = wave_sum(s);
        const float rstd = rsqrtf(s * (1.f / 1024.f) + NORM_EPS);
        f32x4* o4 = (f32x4*)(out + (size_t)row * DM) + lane; const f32x4* g4 = (const f32x4*)g + lane;
#pragma unroll
        for (int j = 0; j < 4; ++j) { f32x4 v = o4[64 * j]; const f32x4 gg = g4[64 * j]; v = v * rstd * gg; o4[64 * j] = v; }
    }
}

namespace pg8 {
__device__ __forceinline__ float row_rstd(const float* ssq, int row) {
    const f32x4* p = (const f32x4*)(ssq + (size_t)row * 16); const f32x4 a = p[0], b = p[1], c = p[2], d = p[3];
    const float s = ((a.x + a.y) + (a.z + a.w)) + ((b.x + b.y) + (b.z + b.w)) + ((c.x + c.y) + (c.z + c.w)) + ((d.x + d.y) + (d.z + d.w));
    return rsqrtf(s * (1.f / 1024.f) + NORM_EPS);
}
template <int ACT> struct EpiAct {
    static constexpr bool PERM = true, AFTER_DRAIN = false;
    bf16_t* O; int ldc; const float* ssq; const float* shw; int ncol;
    __device__ __forceinline__ void operator()(const f32x4 (&acc)[2][2][4][2], const Unit& u, int wr, int wc, int fr, int fq) const {
        const int row0 = u.pm * BM + wr * 64 + fr, mb = u.pm < 128 ? (u.pm >> 5) : 4;
        const int col0 = u.pn * BM + wc * 32 + 8 * fq;
        f32x4 bv[2][2];
#pragma unroll
        for (int bj = 0; bj < 2; ++bj)
#pragma unroll
            for (int n = 0; n < 2; ++n) bv[bj][n] = *(const f32x4*)(shw + (size_t)mb * ncol + col0 + bj * HALF + 4 * n);
        const bool do_silu = (ACT == 2) && (u.pn < 4);
#pragma unroll
        for (int ai = 0; ai < 2; ++ai)
#pragma unroll
            for (int m = 0; m < 4; ++m) { const int row = row0 + ai * HALF + m * 16; const float rs = row_rstd(ssq, row);
                bf16_t* rowp = O + (size_t)row * ldc + col0;
#pragma unroll
                for (int bj = 0; bj < 2; ++bj) { f32x4 v0 = acc[ai][bj][m][0] * rs + bv[bj][0], v1 = acc[ai][bj][m][1] * rs + bv[bj][1];
                    if (ACT == 1) {
#pragma unroll
                        for (int j = 0; j < 4; ++j) { const float a = fmaxf(v0[j], 0.f), b = fmaxf(v1[j], 0.f); v0[j] = a * a; v1[j] = b * b; } }
                    if (ACT == 2) { if (do_silu) {
#pragma unroll
                        for (int j = 0; j < 4; ++j) { v0[j] = siluf_(v0[j]); v1[j] = siluf_(v1[j]); } } }
                    u32x4 w; w.x = cvt_pk_bf16(v0[0], v0[1]); w.y = cvt_pk_bf16(v0[2], v0[3]); w.z = cvt_pk_bf16(v1[0], v1[1]); w.w = cvt_pk_bf16(v1[2], v1[3]);
                    *(u32x4*)(rowp + bj * HALF) = w; } }
    }
};
template <bool HB> struct EpiRes {
    static constexpr bool PERM = false, AFTER_DRAIN = false;
    const float* hin_lat; const float* hin_ctx; float* hout_lat; float* hout_ctx; const float* gate; const float* gsn; bf16_t* hb; float* ssq;
    __device__ __forceinline__ void operator()(const f32x4 (&acc)[2][2][4][2], const Unit& u, int wr, int wc, int fr, int fq) const {
        const bool lat = u.pm < 128; const int mb = lat ? (u.pm >> 5) : 4;
        const int row0 = u.pm * BM + wr * 64 + fr, col0 = u.pn * BM + wc * 32 + 4 * fq;
        const float* hin = lat ? hin_lat : hin_ctx - (size_t)MLAT * DM; float* hout = lat ? hout_lat : hout_ctx - (size_t)MLAT * DM;
        f32x4 gv[2][2], gn[2][2];
#pragma unroll
        for (int bj = 0; bj < 2; ++bj)
#pragma unroll
            for (int n = 0; n < 2; ++n) { gv[bj][n] = *(const f32x4*)(gate + (size_t)mb * 6144 + col0 + bj * HALF + n * 16);
                if (HB) gn[bj][n] = *(const f32x4*)(gsn + (size_t)mb * 1024 + col0 + bj * HALF + n * 16); }
#pragma unroll
        for (int ai = 0; ai < 2; ++ai)
#pragma unroll
            for (int m = 0; m < 4; ++m) { const int row = row0 + ai * HALF + m * 16; const size_t off = (size_t)row * DM + col0; float s = 0.f;
#pragma unroll
                for (int bj = 0; bj < 2; ++bj)
#pragma unroll
                    for (int n = 0; n < 2; ++n) { const f32x4 hi = *(const f32x4*)(hin + off + bj * HALF + n * 16); const f32x4 ho = hi + gv[bj][n] * acc[ai][bj][m][n];
                        *(f32x4*)(hout + off + bj * HALF + n * 16) = ho; s += (ho.x * ho.x + ho.y * ho.y) + (ho.z * ho.z + ho.w * ho.w);
                        if (HB) { const f32x4 hn = ho * gn[bj][n]; u32x2 w; w.x = cvt_pk_bf16(hn.x, hn.y); w.y = cvt_pk_bf16(hn.z, hn.w); *(u32x2*)(hb + off + bj * HALF + n * 16) = w; } }
                s += __shfl_xor(s, 16); s += __shfl_xor(s, 32);
                if (fq == 0) ssq[(size_t)row * 16 + u.pn * 4 + wc] = s;
                asm volatile("" ::: "memory"); }
    }
};
}

template <class Epi>
__global__ void __launch_bounds__(512, 2) k_gemm(pg8::Gemm g, Epi E) {
    extern __shared__ __attribute__((aligned(16))) unsigned char lds[];
    pg8::StaticOrder S; S.init(g.M, g.N, gridDim.x, blockIdx.x);
    pg8::gemm_phase<Epi, pg8::StaticOrder, true, true>((PG8_LAS unsigned char*)lds, g, S, E);
}

struct RwkvW { const float *mu_prev, *mu_next, *w0, *w_up, *a0, *a_up, *g_up, *k_k, *k_a, *r_k, *ln_g, *ln_b; };
struct RwkvTmp { bf16_t *r, *k, *v, *kk, *a0, *a1, *g; float *lw0, *lw1, *osum; };
__device__ __forceinline__ void lrow_info(int lr, int b0, int nbh, int& grow, int& t, int& slen) {
    if (lr < nbh * TL) { const int b = b0 + lr / TL; t = lr % TL; grow = b * TL + t; slen = TL; }
    else { const int l2 = lr - nbh * TL; const int b = b0 + l2 / LC; t = l2 % LC; grow = MLAT + b * LC + t; slen = LC; }
}
__device__ __forceinline__ float shifted(const bf16_t* p0, int grow, int t, int slen, int col, float mup, float mun) {
    const float x = bf2f(p0[(size_t)grow * NIN0 + col]);
    const float xp = t > 0 ? bf2f(p0[(size_t)(grow - 1) * NIN0 + col]) : 0.f;
    const float xn = t < slen - 1 ? bf2f(p0[(size_t)(grow + 1) * NIN0 + col]) : 0.f;
    return x + (xp - x) * mup + (xn - x) * mun;
}
constexpr int PREP_TOK = 8;
__global__ void __launch_bounds__(256) k_rwkv_prep(const bf16_t* p0, RwkvW W, RwkvTmp T, float* bc, int b0, int nbh) {
    __shared__ float lin[PREP_TOK][256];
    const int tid = threadIdx.x, lane = tid & 63;
    const int nrows = nbh * (TL + LC);
    for (int base = blockIdx.x * PREP_TOK; base < nrows; base += gridDim.x * PREP_TOK) {
        __syncthreads();
        {   const int col = 1536 + tid; const float mup = W.mu_prev[col], mun = W.mu_next[col];
#pragma unroll
            for (int tk = 0; tk < PREP_TOK; ++tk) { int grow, t, slen; lrow_info(base + tk, b0, nbh, grow, t, slen);
                const float x = shifted(p0, grow, t, slen, col, mup, mun);
                lin[tk][tid] = tid < 64 ? tanhf(x) : (tid < 128 ? x : sigmoidf_(x)); } }
        __syncthreads();
#pragma unroll 1
        for (int cc = 0; cc < 2; ++cc) { const int c = tid + cc * 256;
            float wl0[PREP_TOK], wl1[PREP_TOK], av0[PREP_TOK], av1[PREP_TOK], gv[PREP_TOK];
#pragma unroll
            for (int tk = 0; tk < PREP_TOK; ++tk) { wl0[tk] = W.w0[c]; wl1[tk] = W.w0[512 + c]; av0[tk] = W.a0[c]; av1[tk] = W.a0[512 + c]; gv[tk] = 0.f; }
#pragma unroll 4
            for (int j = 0; j < 64; ++j) { const float u0 = W.w_up[(size_t)j * 512 + c], u1 = W.w_up[(size_t)(64 + j) * 512 + c], q0 = W.a_up[(size_t)j * 512 + c], q1 = W.a_up[(size_t)(64 + j) * 512 + c];
#pragma unroll
                for (int tk = 0; tk < PREP_TOK; ++tk) { const float tl = lin[tk][j], al = lin[tk][64 + j]; wl0[tk] += tl * u0; wl1[tk] += tl * u1; av0[tk] += al * q0; av1[tk] += al * q1; } }
#pragma unroll 4
            for (int j = 0; j < 128; ++j) { const float gu = W.g_up[(size_t)j * 512 + c];
#pragma unroll
                for (int tk = 0; tk < PREP_TOK; ++tk) gv[tk] += lin[tk][128 + j] * gu; }
            const float mpr = W.mu_prev[c], mnr = W.mu_next[c], mpk = W.mu_prev[512 + c], mnk = W.mu_next[512 + c], mpv = W.mu_prev[1024 + c], mnv = W.mu_next[1024 + c];
            const float kkc = W.k_k[c], kac = W.k_a[c], rkc = W.r_k[c];
#pragma unroll
            for (int tk = 0; tk < PREP_TOK; ++tk) { int grow, t, slen; lrow_info(base + tk, b0, nbh, grow, t, slen);
                const float r = shifted(p0, grow, t, slen, c, mpr, mnr), k = shifted(p0, grow, t, slen, 512 + c, mpk, mnk), v = shifted(p0, grow, t, slen, 1024 + c, mpv, mnv);
                const float sp0 = wl0[tk] > 15.f ? 0.f : log1pf(__expf(-wl0[tk])), sp1 = wl1[tk] > 15.f ? 0.f : log1pf(__expf(-wl1[tk]));
                const float lw0 = -__expf(-(wl0[tk] < -15.f ? -wl0[tk] : sp0) - 0.5f), lw1 = -__expf(-(wl1[tk] < -15.f ? -wl1[tk] : sp1) - 0.5f);
                const float a0 = sigmoidf_(av0[tk]), a1 = sigmoidf_(av1[tk]);
                float kk = k * kkc; const float n2 = wave_sum(kk * kk); kk = kk / fmaxf(sqrtf(n2), 1e-12f);
                const float kd0 = k * (1.f + (a0 - 1.f) * kac), kd1 = k * (1.f + (a1 - 1.f) * kac);
                const float bsum = wave_sum(r * rkc * (kd0 + kd1));
                const size_t o = (size_t)(base + tk) * 512 + c;
                T.r[o] = f2bf(r); T.k[o] = f2bf(k); T.v[o] = f2bf(v); T.kk[o] = f2bf(kk); T.a0[o] = f2bf(a0); T.a1[o] = f2bf(a1); T.g[o] = f2bf(gv[tk]); T.lw0[o] = lw0; T.lw1[o] = lw1;
                if (lane == 0) bc[(size_t)grow * 8 + (c >> 6)] = bsum; }
        }
    }
}

struct ScanIn { u32x4 r[2], k[2], kk[2], a[2]; f32x4 lw[4]; float v; };
__device__ __forceinline__ void scan_load(ScanIn& I, const RwkvTmp& T, int dir, size_t lrow, int h, int v, int kq) {
    const size_t o = lrow * 512 + h * 64 + kq * 16;
    const u32x4* pr = (const u32x4*)(T.r + o); const u32x4* pk = (const u32x4*)(T.k + o); const u32x4* pkk = (const u32x4*)(T.kk + o); const u32x4* pa = (const u32x4*)((dir ? T.a1 : T.a0) + o);
    const f32x4* pl = (const f32x4*)((dir ? T.lw1 : T.lw0) + o);
    I.r[0] = pr[0]; I.r[1] = pr[1]; I.k[0] = pk[0]; I.k[1] = pk[1]; I.kk[0] = pkk[0]; I.kk[1] = pkk[1]; I.a[0] = pa[0]; I.a[1] = pa[1];
    I.lw[0] = pl[0]; I.lw[1] = pl[1]; I.lw[2] = pl[2]; I.lw[3] = pl[3];
    I.v = bf2f(T.v[lrow * 512 + h * 64 + v]);
}
__device__ __forceinline__ float bfu(unsigned w, int hi) { return __uint_as_float(hi ? (w & 0xffff0000u) : (w << 16)); }
__global__ void __launch_bounds__(256) k_rwkv_scan(RwkvTmp T, const float* k_a, int nbh) {
    const int chain = blockIdx.x, dir = chain / (nbh * 8), lb = (chain / 8) % nbh, h = chain & 7;
    const int tid = threadIdx.x, v = tid >> 2, kq = tid & 3;
    float S[16], ka[16];
#pragma unroll
    for (int i = 0; i < 16; ++i) { S[i] = 0.f; ka[i] = k_a[h * 64 + kq * 16 + i]; }
    const int nsteps = LC + TL;
    auto lrow_of = [&](int s) -> size_t { if (s < LC) { const int t = dir ? LC - 1 - s : s; return (size_t)nbh * TL + lb * LC + t; } const int s2 = s - LC; const int t = dir ? TL - 1 - s2 : s2; return (size_t)lb * TL + t; };
    ScanIn cur, nxt; scan_load(cur, T, dir, lrow_of(0), h, v, kq);
    for (int s = 0; s < nsteps; ++s) {
        const size_t lrow = lrow_of(s);
        if (s + 1 < nsteps) scan_load(nxt, T, dir, lrow_of(s + 1), h, v, kq); else nxt = cur;
        float r[16], k[16], kk[16], a[16], w[16];
#pragma unroll
        for (int i = 0; i < 16; ++i) { const int q = i >> 3, j = (i >> 1) & 3, hi = i & 1; r[i] = bfu(cur.r[q][j], hi); k[i] = bfu(cur.k[q][j], hi); kk[i] = bfu(cur.kk[q][j], hi); a[i] = bfu(cur.a[q][j], hi); w[i] = __expf(cur.lw[i >> 2][i & 3]); }
        float skk = 0.f;
#pragma unroll
        for (int i = 0; i < 16; ++i) skk += S[i] * kk[i];
        skk += __shfl_xor(skk, 1); skk += __shfl_xor(skk, 2);
        float o = 0.f;
#pragma unroll
        for (int i = 0; i < 16; ++i) { const float kd = k[i] * (1.f + (a[i] - 1.f) * ka[i]); S[i] = S[i] * w[i] - skk * (kk[i] * a[i]) + cur.v * kd; o += S[i] * r[i]; }
        o += __shfl_xor(o, 1); o += __shfl_xor(o, 2);
        if (kq == 0) atomicAdd(T.osum + lrow * 512 + h * 64 + v, o);
        cur = nxt;
    }
}
__global__ void __launch_bounds__(512) k_rwkv_post(RwkvTmp T, const float* bc, const float* ln_g, const float* ln_b, bf16_t* mix, int b0, int nbh) {
    const int w = threadIdx.x >> 6, lane = threadIdx.x & 63; const int nrows = nbh * (TL + LC);
    for (int lr = blockIdx.x * 8 + w; lr < nrows; lr += gridDim.x * 8) { int grow, t, slen; lrow_info(lr, b0, nbh, grow, t, slen);
        const float* op = T.osum + (size_t)lr * 512 + lane * 8; float o[8]; float s = 0.f;
#pragma unroll
        for (int i = 0; i < 8; ++i) { o[i] = op[i]; s += o[i]; }
        s += __shfl_xor(s, 1); s += __shfl_xor(s, 2); s += __shfl_xor(s, 4); const float mu = s * (1.f / 64.f); float q = 0.f;
#pragma unroll
        for (int i = 0; i < 8; ++i) { const float d = o[i] - mu; q += d * d; }
        q += __shfl_xor(q, 1); q += __shfl_xor(q, 2); q += __shfl_xor(q, 4); const float rs = rsqrtf(q * (1.f / 64.f) + 64e-5f);
        const float bcv = bc[(size_t)grow * 8 + (lane >> 3)]; unsigned pk[4];
#pragma unroll
        for (int i = 0; i < 8; i += 2) { float y[2];
#pragma unroll
            for (int e = 0; e < 2; ++e) { const int c = lane * 8 + i + e; const float vv = bf2f(T.v[(size_t)lr * 512 + c]), gg = bf2f(T.g[(size_t)lr * 512 + c]);
                y[e] = ((o[i + e] - mu) * rs * ln_g[c] + ln_b[c] + bcv * vv) * gg; }
            pk[i >> 1] = pk2(y[0], y[1]); }
        u32x4 st; st.x = pk[0]; st.y = pk[1]; st.z = pk[2]; st.w = pk[3];
        *(u32x4*)(mix + (size_t)grow * DM + lane * 8) = st;
    }
}

__global__ void __launch_bounds__(512) k_na(const bf16_t* p0, const float* rpb, bf16_t* mix) {
    __shared__ float pbuf[8][384];
    const int w = threadIdx.x >> 6, lane = threadIdx.x & 63;
    const int ntask = MALL * 8;
    for (int task = blockIdx.x * 8 + w; task < ntask; task += gridDim.x * 8) {
        const int grow = task >> 3, h = task & 7;
        const bool lat = grow < MLAT;
        const int b = lat ? grow >> 13 : (grow - MLAT) >> 8;
        const int tq = lat ? grow & 8191 : 0, rq = tq >> 6, cq = tq & 63;
        const int r0 = min(max(rq - 4, 0), 120), c0 = min(max(cq - 8, 0), 48);
        const int nkeys = lat ? 384 : 256;
        float q[64];
        { const u32x4* qp = (const u32x4*)(p0 + (size_t)grow * NIN0 + 1792 + h * 64);
#pragma unroll
          for (int i = 0; i < 8; ++i) { const u32x4 x = qp[i];
#pragma unroll
              for (int j = 0; j < 4; ++j) { q[i * 8 + 2 * j] = bfu(x[j], 0); q[i * 8 + 2 * j + 1] = bfu(x[j], 1); } } }
        float sc[6]; float mx = -1e30f;
#pragma unroll
        for (int jj = 0; jj < 6; ++jj) { const int j = jj * 64 + lane; sc[jj] = -1e30f;
            if (j < nkeys) { int krow; float bias = 0.f;
                if (lat && j < 128) { const int kr = j >> 4, kc = j & 15; krow = b * TL + (r0 + kr) * 64 + c0 + kc; bias = rpb[(h * 15 + (r0 + kr - rq + 7)) * 31 + (c0 + kc - cq + 15)]; }
                else { const int l = lat ? j - 128 : j; krow = MLAT + b * LC + l; }
                const u32x4* kp = (const u32x4*)(p0 + (size_t)krow * NIN0 + 2304 + h * 64); float d = 0.f;
#pragma unroll
                for (int i = 0; i < 8; ++i) { const u32x4 x = kp[i];
#pragma unroll
                    for (int jx = 0; jx < 4; ++jx) d += q[i * 8 + 2 * jx] * bfu(x[jx], 0) + q[i * 8 + 2 * jx + 1] * bfu(x[jx], 1); }
                sc[jj] = d * 0.125f + bias; }
            mx = fmaxf(mx, sc[jj]); }
#pragma unroll
        for (int o = 1; o < 64; o <<= 1) mx = fmaxf(mx, __shfl_xor(mx, o));
        float sum = 0.f;
#pragma unroll
        for (int jj = 0; jj < 6; ++jj) { const int j = jj * 64 + lane; const float p = j < nkeys ? __expf(sc[jj] - mx) : 0.f; sum += p; if (j < 384) pbuf[w][j] = p; }
        sum = wave_sum(sum);
        __builtin_amdgcn_s_waitcnt(0xc07f); asm volatile("" ::: "memory");
        float acc = 0.f;
        for (int j = 0; j < nkeys; ++j) { int krow;
            if (lat && j < 128) { const int kr = j >> 4, kc = j & 15; krow = b * TL + (r0 + kr) * 64 + c0 + kc; }
            else { const int l = lat ? j - 128 : j; krow = MLAT + b * LC + l; }
            acc += pbuf[w][j] * bf2f(p0[(size_t)krow * NIN0 + 2816 + h * 64 + lane]); }
        mix[(size_t)grow * DM + 512 + h * 64 + lane] = f2bf(acc / sum);
        __builtin_amdgcn_s_waitcnt(0xc07f); asm volatile("" ::: "memory");
    }
}

__global__ void __launch_bounds__(512) k_hgrn_scan(const bf16_t* p1, const float* lbv, bf16_t* obuf, int dir) {
    const int b = blockIdx.x >> 3, h = blockIdx.x & 7; const int tid = threadIdx.x, v = tid >> 2, kq = tid & 3;
    float S[32], lb[32];
#pragma unroll
    for (int i = 0; i < 32; ++i) { S[i] = 0.f; lb[i] = lbv[h * 128 + kq * 32 + i]; }
    const int nsteps = LC + TL; const int fcol = (dir ? 2048 : 1024) + h * 128 + kq * 32, qcol = h * 128 + kq * 32, icol = 3072 + h * 128 + v;
    auto grow_of = [&](int s) -> size_t { if (s < LC) { const int t = dir ? LC - 1 - s : s; return (size_t)MLAT + b * LC + t; } const int s2 = s - LC; const int t = dir ? TL - 1 - s2 : s2; return (size_t)b * TL + t; };
    u32x4 fq_[4], qq_[4], nf_[4], nq_[4]; float iv, niv;
    { const size_t g0 = grow_of(0); const u32x4* fp = (const u32x4*)(p1 + g0 * NIN1 + fcol); const u32x4* qp = (const u32x4*)(p1 + g0 * NIN1 + qcol);
#pragma unroll
      for (int i = 0; i < 4; ++i) { fq_[i] = fp[i]; qq_[i] = qp[i]; } iv = bf2f(p1[g0 * NIN1 + icol]); }
    for (int s = 0; s < nsteps; ++s) {
        const size_t grow = grow_of(s);
        if (s + 1 < nsteps) { const size_t g1 = grow_of(s + 1); const u32x4* fp = (const u32x4*)(p1 + g1 * NIN1 + fcol); const u32x4* qp = (const u32x4*)(p1 + g1 * NIN1 + qcol);
#pragma unroll
            for (int i = 0; i < 4; ++i) { nf_[i] = fp[i]; nq_[i] = qp[i]; } niv = bf2f(p1[g1 * NIN1 + icol]); }
        float o = 0.f;
#pragma unroll
        for (int i = 0; i < 32; ++i) { const float f = bfu(fq_[i >> 3][(i >> 1) & 3], i & 1), qv = bfu(qq_[i >> 3][(i >> 1) & 3], i & 1);
            const float fg = lb[i] + (1.f - lb[i]) * sigmoidf_(f); S[i] = fg * S[i] + (1.f - fg) * iv; o += S[i] * qv; }
        o += __shfl_xor(o, 1); o += __shfl_xor(o, 2);
        if (kq == 0 && s >= LC) { bf16_t* op = obuf + grow * DM + h * 128 + v; *op = dir ? f2bf(o + bf2f(*op)) : f2bf(o); }
#pragma unroll
        for (int i = 0; i < 4; ++i) { fq_[i] = nf_[i]; qq_[i] = nq_[i]; } iv = niv;
    }
}
__global__ void __launch_bounds__(512) k_hgrn_out(bf16_t* obuf, const bf16_t* p1, const float* g) {
    const int w = threadIdx.x >> 6, lane = threadIdx.x & 63;
    for (int row = blockIdx.x * 8 + w; row < MLAT; row += gridDim.x * 8) {
        bf16_t* op = obuf + (size_t)row * DM + lane * 16; const bf16_t* gp = p1 + (size_t)row * NIN1 + 4096 + lane * 16;
        float o[16]; float s = 0.f;
#pragma unroll
        for (int i = 0; i < 16; ++i) { o[i] = bf2f(op[i]); s += o[i] * o[i]; }
        s = wave_sum(s); const float rs = rsqrtf(s * (1.f / 1024.f) + NORM_EPS);
#pragma unroll
        for (int i = 0; i < 16; ++i) op[i] = f2bf(o[i] * rs * g[lane * 16 + i] * siluf_(bf2f(gp[i])));
    }
}

template <class T> static T zeroed() { T t; memset((void*)&t, 0, sizeof(T)); return t; }
static pg8::Gemm mk_gemm(const bf16_t* A, const bf16_t* Bt, int M, int N, int K) { pg8::Gemm g = zeroed<pg8::Gemm>(); g.A = A; g.Bt = Bt; g.M = M; g.N = N; g.K = K; return g; }
template <int ACT> static pg8::EpiAct<ACT> mk_act(bf16_t* O, int ldc, const float* ssq, const float* shw, int ncol) { pg8::EpiAct<ACT> e = zeroed<pg8::EpiAct<ACT>>(); e.O = O; e.ldc = ldc; e.ssq = ssq; e.shw = shw; e.ncol = ncol; return e; }
template <bool HB> static pg8::EpiRes<HB> mk_res(const float* hin_lat, const float* hin_ctx, float* hout_lat, float* hout_ctx, const float* gate, const float* gsn, bf16_t* hb, float* ssq) {
    pg8::EpiRes<HB> e = zeroed<pg8::EpiRes<HB>>(); e.hin_lat = hin_lat; e.hin_ctx = hin_ctx; e.hout_lat = hout_lat; e.hout_ctx = hout_ctx; e.gate = gate; e.gsn = gsn; e.hb = hb; e.ssq = ssq; return e; }
template <class Epi> static void launch_gemm(const pg8::Gemm& g, const Epi& E, hipStream_t st) {
    static bool attr = false;
    if (!attr) { (void)hipFuncSetAttribute((const void*)k_gemm<Epi>, hipFuncAttributeMaxDynamicSharedMemorySize, pg8::STAGE_BYTES); attr = true; }
    hipLaunchKernelGGL(k_gemm<Epi>, dim3(256), dim3(512), pg8::STAGE_BYTES, st, g, E);
}

extern "C" void kernel_launch(void* const* d_in, const int* in_sizes, int n_in, void* d_out, int out_size, void* d_ws, size_t ws_size, hipStream_t stream) {
    if (ws_size < WS_END) { fprintf(stderr, "workspace too small: %zu < %zu\n", ws_size, (size_t)WS_END); return; }
    const float* x = (const float*)d_in[0]; const float* c = (const float*)d_in[1]; const float* ctx = (const float*)d_in[2]; const float* c_ctx = (const float*)d_in[3];
    const float* norm_mix_g = (const float*)d_in[4]; const float* norm_mlp_g = (const float*)d_in[5]; const float* ada_w = (const float*)d_in[6]; const float* ada_b = (const float*)d_in[7];
    const float* mlp_w1 = (const float*)d_in[8]; const float* mlp_w2 = (const float*)d_in[9]; const float* ev_w_in = (const float*)d_in[10]; const float* ev_w_out = (const float*)d_in[11];
    RwkvW RW{ (const float*)d_in[12], (const float*)d_in[13], (const float*)d_in[14], (const float*)d_in[15], (const float*)d_in[16], (const float*)d_in[17], (const float*)d_in[18],
              (const float*)d_in[19], (const float*)d_in[20], (const float*)d_in[21], (const float*)d_in[22], (const float*)d_in[23] };
    const float* na_rpb = (const float*)d_in[24]; const float* od_w_in = (const float*)d_in[25]; const float* od_w_out = (const float*)d_in[26]; const float* hg_lower = (const float*)d_in[27];
    const float* hg_norm_g = (const float*)d_in[28]; const float* final_norm_g = (const float*)d_in[29];
    char* ws = (char*)d_ws; float* out = (float*)d_out;
    float* mod = (float*)(ws + WS_MOD); float* lb = (float*)(ws + WS_LB); float* gs = (float*)(ws + WS_GS);
    float* shw0 = (float*)(ws + WS_SHW0); float* shw1 = (float*)(ws + WS_SHW1); float* shw2 = (float*)(ws + WS_SHW2); float* shw3 = (float*)(ws + WS_SHW3);
    float* ssq = (float*)(ws + WS_SSQ); float* bc = (float*)(ws + WS_BC); float* hctx = (float*)(ws + WS_HCTX);
    bf16_t* wt = (bf16_t*)(ws + WS_WT); bf16_t* buf0 = (bf16_t*)(ws + WS_BUF0); bf16_t* big = (bf16_t*)(ws + WS_BIG); bf16_t* hbs = (bf16_t*)(ws + WS_BIG + BIG_HB);
    auto WT = [&](size_t off) { return (const bf16_t*)((char*)wt + off); };

    hipLaunchKernelGGL(k_adaln, dim3(192), dim3(512), 0, stream, c, c_ctx, ada_w, ada_b, hg_lower, mod, lb);
    hipLaunchKernelGGL(k_wt, dim3(256), dim3(512), 0, stream, ev_w_in, ev_w_out, mlp_w1, mlp_w2, od_w_in, od_w_out, wt);
    hipLaunchKernelGGL(k_gs, dim3(80), dim3(256), 0, stream, mod, norm_mix_g, norm_mlp_g, gs);
    hipLaunchKernelGGL(k_shw, dim3(260), dim3(512), 0, stream, mod, ev_w_in, mlp_w1, od_w_in, shw0, shw1, shw2, shw3);
    hipLaunchKernelGGL(k_norm_in, dim3(1024), dim3(512), 0, stream, x, ctx, gs, buf0, ssq);
    launch_gemm(mk_gemm(buf0, WT(WT_IN0), MALL, NIN0, DM), mk_act<0>(big, NIN0, ssq, shw0, NIN0), stream);
    for (int hb = 0; hb < 2; ++hb) {
        const size_t RH = (size_t)2 * (TL + LC), AB = RH * 512 * 2, AF = RH * 512 * 4;
        char* t0 = (char*)d_out; char* t1 = ws + WS_BIG + BIG_P0END;
        RwkvTmp T; T.lw0 = (float*)t0; T.lw1 = (float*)(t0 + AF); T.osum = (float*)(t0 + 2 * AF); T.r = (bf16_t*)(t0 + 3 * AF);
        T.k = (bf16_t*)t1; T.v = (bf16_t*)(t1 + AB); T.kk = (bf16_t*)(t1 + 2 * AB); T.a0 = (bf16_t*)(t1 + 3 * AB); T.a1 = (bf16_t*)(t1 + 4 * AB); T.g = (bf16_t*)(t1 + 5 * AB);
        (void)hipMemsetAsync(T.osum, 0, AF, stream);
        hipLaunchKernelGGL(k_rwkv_prep, dim3(1056), dim3(256), 0, stream, (const bf16_t*)big, RW, T, bc, hb * 2, 2);
        hipLaunchKernelGGL(k_rwkv_scan, dim3(2 * 2 * 8), dim3(256), 0, stream, T, RW.k_a, 2);
        hipLaunchKernelGGL(k_rwkv_post, dim3(1024), dim3(512), 0, stream, T, (const float*)bc, RW.ln_g, RW.ln_b, buf0, hb * 2, 2);
    }
    hipLaunchKernelGGL(k_na, dim3(2048), dim3(512), 0, stream, (const bf16_t*)big, na_rpb, buf0);
    launch_gemm(mk_gemm(buf0, WT(WT_OUT0), MALL, DM, DM), mk_res<true>(x, ctx, out, hctx, mod + 2 * 1024, gs + 1 * 5 * 1024, hbs, ssq), stream);
    launch_gemm(mk_gemm(hbs, WT(WT_W10), MALL, NHID, DM), mk_act<1>(big, NHID, ssq, shw1, NHID), stream);
    launch_gemm(mk_gemm(big, WT(WT_W20), MALL, DM, NHID), mk_res<true>(out, hctx, out, hctx, mod + 5 * 1024, gs + 2 * 5 * 1024, buf0, ssq), stream);
    launch_gemm(mk_gemm(buf0, WT(WT_IN1), MALL, NIN1, DM), mk_act<2>(big, NIN1, ssq, shw2, NIN1), stream);
    hipLaunchKernelGGL(k_hgrn_scan, dim3(32), dim3(512), 0, stream, (const bf16_t*)big, (const float*)lb, buf0, 0);
    hipLaunchKernelGGL(k_hgrn_scan, dim3(32), dim3(512), 0, stream, (const bf16_t*)big, (const float*)lb, buf0, 1);
    hipLaunchKernelGGL(k_hgrn_out, dim3(1024), dim3(512), 0, stream, buf0, (const bf16_t*)big, hg_norm_g);
    const float* mod1 = mod + (size_t)5 * 6144;
    launch_gemm(mk_gemm(buf0, WT(WT_OUT1), MLAT, DM, DM), mk_res<true>(out, hctx, out, hctx, mod1 + 2 * 1024, gs + 3 * 5 * 1024, hbs, ssq), stream);
    launch_gemm(mk_gemm(hbs, WT(WT_W11), MLAT, NHID, DM), mk_act<1>(big, NHID, ssq, shw3, NHID), stream);
    launch_gemm(mk_gemm(big, WT(WT_W21), MLAT, DM, NHID), mk_res<false>(out, hctx, out, hctx, mod1 + 5 * 1024, nullptr, nullptr, ssq), stream);
    hipLaunchKernelGGL(k_final, dim3(1024), dim3(512), 0, stream, out, (const float*)ssq, final_norm_g);
}
```

```cpp
#include <hip/hip_runtime.h>
#include <cstdio>
#include <cstdint>
#include <cstring>
namespace pg8 {
#define PG8_LAS __attribute__((address_space(3)))
typedef unsigned short bf16_t;
typedef short bf16x8 __attribute__((ext_vector_type(8)));
typedef float f32x4 __attribute__((ext_vector_type(4)));
typedef unsigned u32x4 __attribute__((ext_vector_type(4)));
constexpr int BM = 256, BK = 64, HALF = 128, HTB = HALF * BK * 2  , STAGE_BYTES = 8 * HTB, NXCD = 8, WGM = 8;

__host__ __device__ __forceinline__ int lds_byte(int r, int c) { const int st = (r >> 4) * 2 + (c >> 5), rr = r & 15, cc = c & 31, ob = rr * 64 + cc * 2; return st * 1024 + (ob ^ (((ob >> 9) & 1) << 5)); }
__host__ __device__ __forceinline__ void stage_rc(int b, int& R, int& C) { const int st = b / 1024, sb = b % 1024, swz = sb ^ (((sb >> 9) & 1) << 5); R = (st >> 1) * 16 + swz / 64; C = (st & 1) * 32 + (swz % 64) / 2; }
__host__ __device__ __forceinline__ int perm32(int rho) { const int n = rho >> 4, i = rho & 15; return 8 * (i >> 2) + 4 * n + (i & 3); }

struct Unit { int pm, pn; };
struct Gemm { const bf16_t* A; const bf16_t* Bt; int M, N, K; };

struct StaticOrder {
    int nM, nN, nwg, G, c;
    __host__ __device__ void init(int M, int N, int G_, int c_) { nM = M / BM; nN = N / BM; nwg = nM * nN; G = G_; c = c_; }
    __host__ __device__ bool next(int i, Unit& u) const {
        const long L = (long)i * G + c; if (L >= nwg) return false;
        int wgid = (int)L; { const int q = nwg / NXCD, r = nwg % NXCD, xcd = wgid % NXCD, off = wgid / NXCD; wgid = (xcd < r ? xcd * (q + 1) : r * (q + 1) + (xcd - r) * q) + off; }
        const int nig = WGM * nN, gid = wgid / nig, fm = gid * WGM, gsz = (nM - fm) < WGM ? (nM - fm) : WGM;
        u.pm = fm + ((wgid % nig) % gsz); u.pn = (wgid % nig) / gsz; return true;
    }
    __device__ __forceinline__ void a_ready(const Unit&) const {}
    __device__ __forceinline__ void done(const Unit&) const {}
};
__device__ __forceinline__ unsigned cvt_pk_bf16(float lo, float hi) { unsigned r; asm volatile("v_cvt_pk_bf16_f32 %0, %1, %2" : "=v"(r) : "v"(lo), "v"(hi)); return r; }
template <class Epi, class Sched, bool ALIGN_EPI = false, bool SP2 = false>
__device__ __forceinline__ void gemm_phase(PG8_LAS unsigned char* lds, const Gemm g, const Sched& S, const Epi& E) {
    const int tid = threadIdx.x, wid = __builtin_amdgcn_readfirstlane(tid >> 6), lane = tid & 63, wr = wid >> 2, wc = wid & 3, fr = lane & 15, fq = lane >> 4;
    const int K = g.K, nt = K / BK;
    unsigned voffA[2], voffB[2];
#pragma unroll
    for (int i = 0; i < 2; ++i) { int R, C; stage_rc(tid * 16 + i * 8192, R, C); const int Rb = Epi::PERM ? ((R & ~31) + perm32(R & 31)) : R;
        voffA[i] = (unsigned)(R * K + C) * 2u; voffB[i] = (unsigned)(Rb * K + C) * 2u; }
    const size_t kstep = (size_t)(BK * 2);
    const size_t hstep = (size_t)HALF * K * 2;
    const size_t tstep = 2 * hstep;
    const unsigned ldsw = (unsigned)wid * 1024u;
    const int aoff = lds_byte(wr * 64 + fr, fq * 8), boff = lds_byte(wc * 32 + fr, fq * 8);
#define PG8_SA(b, h) (((b) * 2 + (h)) * HTB)
#define PG8_SB(b, h) ((4 + (b) * 2 + (h)) * HTB)
#define PG8_STAGE(bufoff, gbase, voff) do { _Pragma("unroll") for (int _i = 0; _i < 2; ++_i) \
        __builtin_amdgcn_global_load_lds((const unsigned*)((const char*)(gbase) + (voff)[_i]), (PG8_LAS unsigned*)(lds + (bufoff) + ldsw + _i * 8192), 16, 0, 0); } while (0)
#define PG8_LDA(dst, b, h) do { _Pragma("unroll") for (int m = 0; m < 4; ++m) _Pragma("unroll") for (int k = 0; k < 2; ++k) dst[m][k] = *(const PG8_LAS bf16x8*)(lds + PG8_SA(b, h) + aoff + m * 2048 + k * 1024); } while (0)
#define PG8_LDB(dst, b, h) do { _Pragma("unroll") for (int n = 0; n < 2; ++n) _Pragma("unroll") for (int k = 0; k < 2; ++k) dst[n][k] = *(const PG8_LAS bf16x8*)(lds + PG8_SB(b, h) + boff + n * 2048 + k * 1024); } while (0)
#define PG8_MMA(ai, bj, At, Bt) do { __builtin_amdgcn_s_setprio(1); _Pragma("unroll") for (int m = 0; m < 4; ++m) _Pragma("unroll") for (int n = 0; n < 2; ++n) _Pragma("unroll") for (int k = 0; k < 2; ++k) \
        acc[ai][bj][m][n] = __builtin_amdgcn_mfma_f32_16x16x32_bf16(Bt[n][k], At[m][k], acc[ai][bj][m][n], 0, 0, 0); __builtin_amdgcn_s_setprio(0); } while (0)
#define PG8_WAIT_V(n) asm volatile("s_waitcnt vmcnt(" #n ")" ::: "memory")
#define PG8_WAIT_L(n) asm volatile("s_waitcnt lgkmcnt(" #n ")" ::: "memory")
#define PG8_BAR __builtin_amdgcn_s_barrier()
#define PG8_SCHED __builtin_amdgcn_sched_barrier(0)
    Unit cur, nxt; int ui = 0;
    if (!S.next(0, cur)) return;
    f32x4 acc[2][2][4][2];
#pragma unroll
    for (int a = 0; a < 2; ++a)
#pragma unroll
        for (int b = 0; b < 2; ++b)
#pragma unroll
            for (int m = 0; m < 4; ++m)
#pragma unroll
                for (int n = 0; n < 2; ++n) acc[a][b][m][n] = (f32x4){0.f, 0.f, 0.f, 0.f};
    bf16x8 At[4][2], B0[2][2], B1[2][2];
    const char* cA = (const char*)g.A + (size_t)cur.pm * tstep; const char* cB = (const char*)g.Bt + (size_t)cur.pn * tstep;
    S.a_ready(cur);
    if constexpr (SP2) {
        PG8_STAGE(PG8_SB(0, 0), cB, voffB); PG8_STAGE(PG8_SB(0, 1), cB + hstep, voffB); PG8_STAGE(PG8_SA(0, 0), cA, voffA); PG8_STAGE(PG8_SA(0, 1), cA + hstep, voffA);
        if (wr == 1) PG8_BAR;
        PG8_WAIT_V(2); PG8_BAR;
        PG8_STAGE(PG8_SB(1, 0), cB + kstep, voffB); PG8_STAGE(PG8_SA(1, 0), cA + kstep, voffA); PG8_STAGE(PG8_SB(1, 1), cB + hstep + kstep, voffB);
        PG8_WAIT_V(6); PG8_BAR;
    } else {
        PG8_STAGE(PG8_SB(0, 0), cB, voffB); PG8_STAGE(PG8_SA(0, 0), cA, voffA); PG8_STAGE(PG8_SB(0, 1), cB + hstep, voffB); PG8_STAGE(PG8_SA(0, 1), cA + hstep, voffA);
        if (wr == 1) PG8_BAR;
        PG8_WAIT_V(4); PG8_BAR;
        PG8_STAGE(PG8_SB(1, 0), cB + kstep, voffB); PG8_STAGE(PG8_SA(1, 0), cA + kstep, voffA); PG8_STAGE(PG8_SB(1, 1), cB + hstep + kstep, voffB);
        PG8_WAIT_V(6); PG8_BAR;
    }
    for (;;) {
        const bool has_next = S.next(ui + 1, nxt);
        const char* nA = has_next ? (const char*)g.A + (size_t)nxt.pm * tstep : cA; const char* nB = has_next ? (const char*)g.Bt + (size_t)nxt.pn * tstep : cB;
        for (int t = 0; t < nt; t += 2) {
            const bool last = (t == nt - 2);
            const char* a1 = cA + (size_t)(t + 1) * kstep;
            const char* a2 = last ? nA : cA + (size_t)(t + 2) * kstep; const char* b2 = last ? nB : cB + (size_t)(t + 2) * kstep;
            const char* a3 = a2 + kstep; const char* b3 = b2 + kstep;
            if (last && has_next) S.a_ready(nxt);
            if constexpr (SP2) {
            PG8_LDB(B0, 0, 0); PG8_LDB(B1, 0, 1); PG8_SCHED; PG8_LDA(At, 0, 0); PG8_STAGE(PG8_SA(1, 1), a1 + hstep, voffA);
            PG8_WAIT_V(8); PG8_WAIT_L(0); PG8_BAR; PG8_MMA(0, 0, At, B0); PG8_MMA(0, 1, At, B1); PG8_BAR; PG8_SCHED;
            PG8_LDA(At, 0, 1); PG8_STAGE(PG8_SB(0, 0), b2, voffB); PG8_STAGE(PG8_SB(0, 1), b2 + hstep, voffB); PG8_STAGE(PG8_SA(0, 0), a2, voffA);
            PG8_WAIT_V(8); PG8_WAIT_L(0); PG8_BAR; PG8_MMA(1, 0, At, B0); PG8_MMA(1, 1, At, B1); PG8_BAR; PG8_SCHED;
            PG8_LDB(B0, 1, 0); PG8_LDB(B1, 1, 1); PG8_SCHED; PG8_LDA(At, 1, 0); PG8_STAGE(PG8_SA(0, 1), a2 + hstep, voffA);
            PG8_WAIT_V(8); PG8_WAIT_L(0); PG8_BAR; PG8_MMA(0, 0, At, B0); PG8_MMA(0, 1, At, B1); PG8_BAR; PG8_SCHED;
            PG8_LDA(At, 1, 1); PG8_STAGE(PG8_SB(1, 0), b3, voffB); PG8_STAGE(PG8_SB(1, 1), b3 + hstep, voffB); PG8_STAGE(PG8_SA(1, 0), a3, voffA);
            PG8_WAIT_V(8); PG8_WAIT_L(0); PG8_BAR; PG8_MMA(1, 0, At, B0); PG8_MMA(1, 1, At, B1); PG8_BAR; PG8_SCHED;
            } else {
            PG8_LDB(B0, 0, 0); PG8_SCHED; PG8_LDA(At, 0, 0); PG8_STAGE(PG8_SA(1, 1), a1 + hstep, voffA);
            PG8_WAIT_L(8); PG8_BAR; PG8_WAIT_L(0); PG8_MMA(0, 0, At, B0); PG8_BAR; PG8_SCHED;
            PG8_LDB(B1, 0, 1); PG8_STAGE(PG8_SB(0, 0), b2, voffB);
            PG8_BAR; PG8_WAIT_L(0); PG8_MMA(0, 1, At, B1); PG8_BAR;
            PG8_LDA(At, 0, 1); PG8_STAGE(PG8_SA(0, 0), a2, voffA);
            PG8_BAR; PG8_WAIT_L(0); PG8_MMA(1, 0, At, B0); PG8_BAR; PG8_SCHED;
            PG8_STAGE(PG8_SB(0, 1), b2 + hstep, voffB);
            PG8_WAIT_V(6); PG8_BAR; PG8_MMA(1, 1, At, B1); PG8_BAR;
            PG8_LDB(B0, 1, 0); PG8_SCHED; PG8_LDA(At, 1, 0); PG8_STAGE(PG8_SA(0, 1), a2 + hstep, voffA);
            PG8_WAIT_L(8); PG8_BAR; PG8_WAIT_L(0); PG8_MMA(0, 0, At, B0); PG8_BAR; PG8_SCHED;
            PG8_LDB(B1, 1, 1); PG8_STAGE(PG8_SB(1, 0), b3, voffB);
            PG8_BAR; PG8_WAIT_L(0); PG8_MMA(0, 1, At, B1); PG8_BAR;
            PG8_LDA(At, 1, 1); PG8_STAGE(PG8_SA(1, 0), a3, voffA);
            PG8_BAR; PG8_WAIT_L(0); PG8_MMA(1, 0, At, B0); PG8_BAR; PG8_SCHED;
            PG8_STAGE(PG8_SB(1, 1), b3 + hstep, voffB);
            PG8_WAIT_V(6); PG8_BAR; PG8_MMA(1, 1, At, B1); PG8_BAR;
            }
        }
        if constexpr (ALIGN_EPI) { if (wr == 0) PG8_BAR; }
        if constexpr (!Epi::AFTER_DRAIN) { E(acc, cur, wr, wc, fr, fq); S.done(cur); }
        if (!has_next) break;
#pragma unroll
        for (int a = 0; a < 2; ++a)
#pragma unroll
            for (int b = 0; b < 2; ++b)
#pragma unroll
                for (int m = 0; m < 4; ++m)
#pragma unroll
                    for (int n = 0; n < 2; ++n) acc[a][b][m][n] = (f32x4){0.f, 0.f, 0.f, 0.f};
        cur = nxt; cA = nA; cB = nB; ++ui;
        if constexpr (ALIGN_EPI) { if (wr == 1) PG8_BAR; }
    }
    PG8_WAIT_V(0);
    if constexpr (!ALIGN_EPI) { if (wr == 0) PG8_BAR; }
    PG8_BAR;
    if constexpr (Epi::AFTER_DRAIN) { E.fused(acc, cur, wr, wc, fr, fq, lds, wid, lane); S.done(cur); }
#undef PG8_SA
#undef PG8_SB
#undef PG8_STAGE
#undef PG8_LDA
#undef PG8_LDB
#undef PG8_MMA
#undef PG8_WAIT_V
#undef PG8_WAIT_L
#undef PG8_BAR
#undef PG8_SCHED
}
}

typedef unsigned short bf16_t;
typedef float f32x4 __attribute__((ext_vector_type(4)));
typedef unsigned u32x4 __attribute__((ext_vector_type(4)));
typedef unsigned u32x2 __attribute__((ext_vector_type(2)));
constexpr int DM = 1024, NB = 4, TL = 8192, LC = 256;
constexpr int MLAT = NB * TL, MCTX = NB * LC, MALL = MLAT + MCTX;
constexpr int NIN0 = 3328, NIN1 = 5120, NHID = 4096;
constexpr float NORM_EPS = 1e-6f;

__device__ __forceinline__ float bf2f(bf16_t b) { return __uint_as_float(((unsigned)b) << 16); }
__device__ __forceinline__ bf16_t f2bf(float f) { unsigned u = __float_as_uint(f); u += 0x7fffu + ((u >> 16) & 1u); return (bf16_t)(u >> 16); }
__device__ __forceinline__ unsigned pk2(float lo, float hi) { return (unsigned)f2bf(lo) | ((unsigned)f2bf(hi) << 16); }
__device__ __forceinline__ float sigmoidf_(float x) { return 1.f / (1.f + __expf(-x)); }
__device__ __forceinline__ float siluf_(float x) { return x / (1.f + __expf(-x)); }
__device__ __forceinline__ float wave_sum(float v) {
#pragma unroll
    for (int o = 1; o < 64; o <<= 1) v += __shfl_xor(v, o);
    return v;
}

constexpr size_t WS_CTL  = 0;
constexpr size_t WS_MOD  = 65536;
constexpr size_t WS_LB   = WS_MOD + 2 * 5 * 6144 * 4;
constexpr size_t WS_GS   = WS_LB + 4096;
constexpr size_t WS_SHW0 = WS_GS + 4 * 5 * 1024 * 4;
constexpr size_t WS_SHW1 = WS_SHW0 + 5 * 3328 * 4;
constexpr size_t WS_SHW2 = WS_SHW1 + 5 * 4096 * 4;
constexpr size_t WS_SHW3 = WS_SHW2 + 5 * 5120 * 4;
constexpr size_t WS_SSQ  = WS_SHW3 + 5 * 4096 * 4;
constexpr size_t WS_BC   = WS_SSQ + (size_t)MALL * 64;
constexpr size_t WS_HCTX = WS_BC + (size_t)MALL * 32;
constexpr size_t WS_WT   = WS_HCTX + (size_t)MCTX * DM * 4;
constexpr size_t WT_IN0 = 0, WT_OUT0 = WT_IN0 + (size_t)NIN0 * DM * 2, WT_W10 = WT_OUT0 + (size_t)DM * DM * 2, WT_W20 = WT_W10 + (size_t)NHID * DM * 2,
                 WT_IN1 = WT_W20 + (size_t)NHID * DM * 2, WT_OUT1 = WT_IN1 + (size_t)NIN1 * DM * 2, WT_W11 = WT_OUT1 + (size_t)DM * DM * 2, WT_W21 = WT_W11 + (size_t)NHID * DM * 2,
                 WT_END = WT_W21 + (size_t)NHID * DM * 2;
constexpr size_t WS_BUF0 = WS_WT + WT_END;
constexpr size_t WS_BIG  = WS_BUF0 + (size_t)MALL * DM * 2;
constexpr size_t BIG_HB  = (size_t)MALL * NHID * 2;
constexpr size_t BIG_P0END = (size_t)MALL * NIN0 * 2;
constexpr size_t WS_END  = WS_BIG + (size_t)MALL * NIN1 * 2;

__device__ __forceinline__ void gemv5_item(const float* W, int ldw, int n0, const float* s, float* red, float* out, int ldo, const float* bias) {
    const int tid = threadIdx.x, w = tid >> 6, lane = tid & 63;
    float a0 = 0.f, a1 = 0.f, a2 = 0.f, a3 = 0.f, a4 = 0.f;
    const float* wp = W + (size_t)(w * 128) * ldw + n0 + lane;
#pragma unroll 8
    for (int k = 0; k < 128; ++k) { const float wv = wp[(size_t)k * ldw]; const int kk = w * 128 + k;
        a0 += s[kk] * wv; a1 += s[1024 + kk] * wv; a2 += s[2048 + kk] * wv; a3 += s[3072 + kk] * wv; a4 += s[4096 + kk] * wv; }
    red[(w * 5 + 0) * 64 + lane] = a0; red[(w * 5 + 1) * 64 + lane] = a1; red[(w * 5 + 2) * 64 + lane] = a2; red[(w * 5 + 3) * 64 + lane] = a3; red[(w * 5 + 4) * 64 + lane] = a4;
    __syncthreads();
    if (tid < 320) { const int mb = tid >> 6; float r = bias ? bias[n0 + lane] : 0.f;
#pragma unroll
        for (int ww = 0; ww < 8; ++ww) r += red[(ww * 5 + mb) * 64 + lane];
        out[(size_t)mb * ldo + n0 + lane] = r; }
    __syncthreads();
}

__device__ __forceinline__ void transpose_item(const float* W, int K, int N, bf16_t* WT, float* scr, int item, int lane) {
    const int nblk = N / 32, kb = item / nblk, nb = item % nblk, k0 = 64 * kb, n0 = 32 * nb;
#pragma unroll 8
    for (int i = 0; i < 32; ++i) { const int kk = 2 * i + (lane >> 5); scr[kk * 33 + (lane & 31)] = W[(size_t)(k0 + kk) * N + n0 + (lane & 31)]; }
    __builtin_amdgcn_s_waitcnt(0xc07f); asm volatile("" ::: "memory");
    const int c = lane & 7;
#pragma unroll
    for (int j = 0; j < 4; ++j) { const int n = (lane >> 3) + 8 * j; const float* sp = scr + (8 * c) * 33 + n;
        u32x4 o; o.x = pk2(sp[0 * 33], sp[1 * 33]); o.y = pk2(sp[2 * 33], sp[3 * 33]); o.z = pk2(sp[4 * 33], sp[5 * 33]); o.w = pk2(sp[6 * 33], sp[7 * 33]);
        *(u32x4*)(WT + (size_t)(n0 + n) * K + k0 + 8 * c) = o; }
    __builtin_amdgcn_s_waitcnt(0xc07f); asm volatile("" ::: "memory");
}
namespace pg8 {
__device__ __forceinline__ float row_rstd(const float* ssq, int row) {
    const f32x4* p = (const f32x4*)(ssq + (size_t)row * 16); const f32x4 a = p[0], b = p[1], c = p[2], d = p[3];
    const float s = ((a.x + a.y) + (a.z + a.w)) + ((b.x + b.y) + (b.z + b.w)) + ((c.x + c.y) + (c.z + c.w)) + ((d.x + d.y) + (d.z + d.w));
    return rsqrtf(s * (1.f / 1024.f) + NORM_EPS);
}
template <int ACT> struct EpiAct {
    static constexpr bool PERM = true, AFTER_DRAIN = false;
    bf16_t* O; int ldc; const float* ssq; const float* shw; int ncol;
    __device__ __forceinline__ void operator()(const f32x4 (&acc)[2][2][4][2], const Unit& u, int wr, int wc, int fr, int fq) const {
        const int row0 = u.pm * BM + wr * 64 + fr, mb = u.pm < 128 ? (u.pm >> 5) : 4;
        const int col0 = u.pn * BM + wc * 32 + 8 * fq;
        f32x4 bv[2][2];
#pragma unroll
        for (int bj = 0; bj < 2; ++bj)
#pragma unroll
            for (int n = 0; n < 2; ++n) bv[bj][n] = *(const f32x4*)(shw + (size_t)mb * ncol + col0 + bj * HALF + 4 * n);
        const bool do_silu = (ACT == 2) && (u.pn < 4);
#pragma unroll
        for (int ai = 0; ai < 2; ++ai)
#pragma unroll
            for (int m = 0; m < 4; ++m) { const int row = row0 + ai * HALF + m * 16; const float rs = row_rstd(ssq, row);
                bf16_t* rowp = O + (size_t)row * ldc + col0;
#pragma unroll
                for (int bj = 0; bj < 2; ++bj) { f32x4 v0 = acc[ai][bj][m][0] * rs + bv[bj][0], v1 = acc[ai][bj][m][1] * rs + bv[bj][1];
                    if (ACT == 1) {
#pragma unroll
                        for (int j = 0; j < 4; ++j) { const float a = fmaxf(v0[j], 0.f), b = fmaxf(v1[j], 0.f); v0[j] = a * a; v1[j] = b * b; } }
                    if (ACT == 2) { if (do_silu) {
#pragma unroll
                        for (int j = 0; j < 4; ++j) { v0[j] = siluf_(v0[j]); v1[j] = siluf_(v1[j]); } } }
                    u32x4 w; w.x = cvt_pk_bf16(v0[0], v0[1]); w.y = cvt_pk_bf16(v0[2], v0[3]); w.z = cvt_pk_bf16(v1[0], v1[1]); w.w = cvt_pk_bf16(v1[2], v1[3]);
                    *(u32x4*)(rowp + bj * HALF) = w; } }
    }
};
template <bool HB> struct EpiRes {
    static constexpr bool PERM = false, AFTER_DRAIN = false;
    const float* hin_lat; const float* hin_ctx; float* hout_lat; float* hout_ctx; const float* gate; const float* gsn; bf16_t* hb; float* ssq;
    __device__ __forceinline__ void operator()(const f32x4 (&acc)[2][2][4][2], const Unit& u, int wr, int wc, int fr, int fq) const {
        const bool lat = u.pm < 128; const int mb = lat ? (u.pm >> 5) : 4;
        const int row0 = u.pm * BM + wr * 64 + fr, col0 = u.pn * BM + wc * 32 + 4 * fq;
        const float* hin = lat ? hin_lat : hin_ctx - (size_t)MLAT * DM; float* hout = lat ? hout_lat : hout_ctx - (size_t)MLAT * DM;
        f32x4 gv[2][2], gn[2][2];
#pragma unroll
        for (int bj = 0; bj < 2; ++bj)
#pragma unroll
            for (int n = 0; n < 2; ++n) { gv[bj][n] = *(const f32x4*)(gate + (size_t)mb * 6144 + col0 + bj * HALF + n * 16);
                if (HB) gn[bj][n] = *(const f32x4*)(gsn + (size_t)mb * 1024 + col0 + bj * HALF + n * 16); }
#pragma unroll
        for (int ai = 0; ai < 2; ++ai)
#pragma unroll
            for (int m = 0; m < 4; ++m) { const int row = row0 + ai * HALF + m * 16; const size_t off = (size_t)row * DM + col0; float s = 0.f;
#pragma unroll
                for (int bj = 0; bj < 2; ++bj)
#pragma unroll
                    for (int n = 0; n < 2; ++n) { const f32x4 hi = *(const f32x4*)(hin + off + bj * HALF + n * 16); const f32x4 ho = hi + gv[bj][n] * acc[ai][bj][m][n];
                        *(f32x4*)(hout + off + bj * HALF + n * 16) = ho; s += (ho.x * ho.x + ho.y * ho.y) + (ho.z * ho.z + ho.w * ho.w);
                        if (HB) { const f32x4 hn = ho * gn[bj][n]; u32x2 w; w.x = cvt_pk_bf16(hn.x, hn.y); w.y = cvt_pk_bf16(hn.z, hn.w); *(u32x2*)(hb + off + bj * HALF + n * 16) = w; } }
                s += __shfl_xor(s, 16); s += __shfl_xor(s, 32);
                if (fq == 0) ssq[(size_t)row * 16 + u.pn * 4 + wc] = s;
                asm volatile("" ::: "memory"); }
    }
};
}

struct RwkvW { const float *mu_prev, *mu_next, *w0, *w_up, *a0, *a_up, *g_up, *k_k, *k_a, *r_k, *ln_g, *ln_b; };
struct RwkvTmp { bf16_t *r, *k, *v, *kk, *a0, *a1, *g; float *lw0, *lw1, *osum; };
__device__ __forceinline__ void lrow_info(int lr, int b0, int nbh, int& grow, int& t, int& slen) {
    if (lr < nbh * TL) { const int b = b0 + lr / TL; t = lr % TL; grow = b * TL + t; slen = TL; }
    else { const int l2 = lr - nbh * TL; const int b = b0 + l2 / LC; t = l2 % LC; grow = MLAT + b * LC + t; slen = LC; }
}
__device__ __forceinline__ float shifted(const bf16_t* p0, int grow, int t, int slen, int col, float mup, float mun) {
    const float x = bf2f(p0[(size_t)grow * NIN0 + col]);
    const float xp = t > 0 ? bf2f(p0[(size_t)(grow - 1) * NIN0 + col]) : 0.f;
    const float xn = t < slen - 1 ? bf2f(p0[(size_t)(grow + 1) * NIN0 + col]) : 0.f;
    return x + (xp - x) * mup + (xn - x) * mun;
}
struct ScanIn { u32x4 r[2], k[2], kk[2], a[2]; f32x4 lw[4]; float v; };
__device__ __forceinline__ void scan_load(ScanIn& I, const RwkvTmp& T, int dir, size_t lrow, int h, int v, int kq) {
    const size_t o = lrow * 512 + h * 64 + kq * 16;
    const u32x4* pr = (const u32x4*)(T.r + o); const u32x4* pk = (const u32x4*)(T.k + o); const u32x4* pkk = (const u32x4*)(T.kk + o); const u32x4* pa = (const u32x4*)((dir ? T.a1 : T.a0) + o);
    const f32x4* pl = (const f32x4*)((dir ? T.lw1 : T.lw0) + o);
    I.r[0] = pr[0]; I.r[1] = pr[1]; I.k[0] = pk[0]; I.k[1] = pk[1]; I.kk[0] = pkk[0]; I.kk[1] = pkk[1]; I.a[0] = pa[0]; I.a[1] = pa[1];
    I.lw[0] = pl[0]; I.lw[1] = pl[1]; I.lw[2] = pl[2]; I.lw[3] = pl[3];
    I.v = bf2f(T.v[lrow * 512 + h * 64 + v]);
}
__device__ __forceinline__ float bfu(unsigned w, int hi) { return __uint_as_float(hi ? (w & 0xffff0000u) : (w << 16)); }
#define LAS __attribute__((address_space(3)))
#define GAS __attribute__((address_space(1)))
#define XB_TMO      128
#define XB_XCNT(j)  (256  + 64 * (j))
#define XB_XSUB(j)  (1280 + 64 * (j))
#define XB_XGEN(j)  (2304 + 64 * (j))
#define XB_TOP      3328
#define XB_TOPGEN   3392
#define XCD_BAR_WORDS 3456
#define XB_SPIN_CAP (1u << 18)

__device__ __forceinline__ unsigned xb_ld(unsigned* p)              { return __hip_atomic_load(p, __ATOMIC_RELAXED, __HIP_MEMORY_SCOPE_AGENT); }
__device__ __forceinline__ unsigned xb_add(unsigned* p, unsigned v) { return __hip_atomic_fetch_add(p, v, __ATOMIC_RELAXED, __HIP_MEMORY_SCOPE_AGENT); }
__device__ __forceinline__ unsigned xb_xcc_id() { return (unsigned)__builtin_amdgcn_s_getreg((3 << 11) | 20) & 0xFu; }
#define XB_SPIN(cond, bar) do { unsigned _sp = 0; while (cond) { __builtin_amdgcn_s_sleep(1); \
    if ((++_sp & 255u) == 0u) { if (xb_ld(&(bar)[XB_TMO])) break; if (_sp > XB_SPIN_CAP) { atomicAdd(&(bar)[XB_TMO], 1u); break; } } } } while (0)

struct XcdBarrier {
    unsigned* bar; unsigned x;
    volatile LAS unsigned* st;
};

__device__ __forceinline__ XcdBarrier xcd_barrier_post(unsigned* bar, volatile LAS unsigned* st) {
    XcdBarrier b; b.bar = bar; b.x = xb_xcc_id(); b.st = st;
    if (threadIdx.x == 0) (void)xb_add(&bar[XB_XCNT(b.x)], 1u);
    return b;
}
__device__ __forceinline__ void xcd_barrier_complete(unsigned* bar, unsigned x, unsigned& nloc, unsigned& nx) {
    const unsigned G = gridDim.x * gridDim.y * gridDim.z;
    unsigned sum, cnt, mine, sp = 0u;
    for (;;) {
        sum = 0u; cnt = 0u; mine = 0u;
#pragma unroll
        for (unsigned j = 0; j < 16; ++j) { const unsigned c = xb_ld(&bar[XB_XCNT(j)]); sum += c; cnt += (c > 0u) ? 1u : 0u; mine = (j == x) ? c : mine; }
        if (sum == G) break;
        __builtin_amdgcn_s_sleep(1);
        if ((++sp & 255u) == 0u) { if (xb_ld(&bar[XB_TMO])) break; if (sp > XB_SPIN_CAP) { atomicAdd(&bar[XB_TMO], 1u); break; } }
    }
    nloc = mine > 0u ? mine : 1u; nx = cnt > 0u ? cnt : 1u;
}

__device__ __forceinline__ void xcd_barrier(const XcdBarrier& b) {
    asm volatile("s_waitcnt vmcnt(0)" ::: "memory");
    __syncthreads();
    if (threadIdx.x == 0) {
        unsigned* bar = b.bar;
        __builtin_amdgcn_s_waitcnt(0);
        unsigned nloc = b.st[0], nx = b.st[1];
        if (nloc == 0u) { xcd_barrier_complete(bar, b.x, nloc, nx); b.st[0] = nloc; b.st[1] = nx; }
        const unsigned old = xb_add(&bar[XB_XSUB(b.x)], 1u);
        const unsigned gen = old / nloc;
        if (old + 1u == (gen + 1u) * nloc) {
            __builtin_amdgcn_fence(__ATOMIC_RELEASE, "agent");
            asm volatile("s_waitcnt vmcnt(0)" ::: "memory");
            const unsigned og = xb_add(&bar[XB_TOP], 1u);
            const unsigned tg = og / nx;
            if (og + 1u == (tg + 1u) * nx) xb_add(&bar[XB_TOPGEN], 1u);
            else XB_SPIN(xb_ld(&bar[XB_TOPGEN]) == tg, bar);
            __builtin_amdgcn_fence(__ATOMIC_ACQUIRE, "agent");
            xb_add(&bar[XB_XGEN(b.x)], 1u);
            asm volatile("s_waitcnt vmcnt(0)" ::: "memory");
        } else {
            XB_SPIN(xb_ld(&bar[XB_XGEN(b.x)]) == gen, bar);
            __builtin_amdgcn_fence(__ATOMIC_ACQUIRE, "agent");
            asm volatile("s_waitcnt vmcnt(0)" ::: "memory");
        }
    }
    __syncthreads();
}

constexpr int NWAVES = 8, NTHREADS = 512;
constexpr int RING_BYTES = 131072, LDSCTL_OFF = RING_BYTES, MISC_OFF = LDSCTL_OFF + 320, LDS_BYTES = 147456;
constexpr int CW_BAR = 4096;
constexpr size_t CTL_ZERO_BYTES = 65536;

struct MP { const float* in[30]; float* out; char* ws; int ph_lo, ph_hi; };

__device__ __forceinline__ void ph_adaln(const MP& p, int bid, int nblk, char* lds) {
    const float* c = p.in[1]; const float* c_ctx = p.in[3]; const float* ada_w = p.in[6]; const float* ada_b = p.in[7]; const float* hg_lower = p.in[27];
    float* mod = (float*)(p.ws + WS_MOD); float* lb = (float*)(p.ws + WS_LB);
    float* s = (float*)lds; float* red = s + 5 * 1024;
    const int tid = threadIdx.x;
    __syncthreads();
    for (int i = tid; i < 5 * 1024; i += 512) { const int mb = i >> 10, k = i & 1023; const float x = mb < 4 ? c[mb * 1024 + k] : c_ctx[k]; s[i] = siluf_(x); }
    __syncthreads();
    for (int it = bid; it < 2 * 96; it += nblk) { const int l = it / 96, n0 = (it % 96) * 64;
        gemv5_item(ada_w + (size_t)l * 1024 * 6144, 6144, n0, s, red, mod + (size_t)l * 5 * 6144, 6144, ada_b + l * 6144); }
    if (bid == nblk - 1) for (int k = tid; k < 1024; k += 512) lb[k] = sigmoidf_(hg_lower[1024 + k] - hg_lower[k]);
    __syncthreads();
}
__device__ __forceinline__ void ph_wt(const MP& p, int bid, int nblk, char* lds) {
    const float* w_in0 = p.in[10]; const float* w_out0 = p.in[11]; const float* w1 = p.in[8]; const float* w2 = p.in[9]; const float* w_in1 = p.in[25]; const float* w_out1 = p.in[26];
    char* wt = p.ws + WS_WT;
    const int tid = threadIdx.x, w = tid >> 6, lane = tid & 63;
    float* scr = (float*)lds + w * 64 * 33;
    const int gw = bid * 8 + w, NGW = nblk * 8;
    __syncthreads();
#define WT_JOB(Wp, K_, N_, off_) { const int nitems = ((K_) / 64) * ((N_) / 32); for (int it = gw; it < nitems; it += NGW) transpose_item((Wp), (K_), (N_), (bf16_t*)(wt + (off_)), scr, it, lane); }
    WT_JOB(w_in0, 1024, NIN0, WT_IN0) WT_JOB(w_out0, 1024, 1024, WT_OUT0) WT_JOB(w1, 1024, NHID, WT_W10) WT_JOB(w2, NHID, 1024, WT_W20)
    WT_JOB(w_in1, 1024, NIN1, WT_IN1) WT_JOB(w_out1, 1024, 1024, WT_OUT1) WT_JOB(w1 + (size_t)1024 * NHID, 1024, NHID, WT_W11) WT_JOB(w2 + (size_t)NHID * 1024, NHID, 1024, WT_W21)
#undef WT_JOB
    __syncthreads();
}
__device__ __forceinline__ void ph_gs(const MP& p, int bid, int nblk) {
    const float* mod = (const float*)(p.ws + WS_MOD); const float* norm_mix_g = p.in[4]; const float* norm_mlp_g = p.in[5]; float* gs = (float*)(p.ws + WS_GS);
    for (int i = bid * 512 + threadIdx.x; i < 4 * 5 * 1024; i += nblk * 512) {
        const int w = i / 5120, mb = (i / 1024) % 5, k = i & 1023, l = w >> 1, second = w & 1;
        const float g = second ? norm_mlp_g[l * 1024 + k] : norm_mix_g[l * 1024 + k];
        const float sc = mod[(size_t)(l * 5 + mb) * 6144 + (second ? 4 * 1024 : 1024) + k];
        gs[i] = g * (1.f + sc); }
}
__device__ __forceinline__ void ph_shw(const MP& p, int bid, int nblk, char* lds) {
    const float* mod = (const float*)(p.ws + WS_MOD); const float* w_in0 = p.in[10]; const float* w1 = p.in[8]; const float* w_in1 = p.in[25];
    float* s = (float*)lds; float* red = s + 5 * 1024;
    const int tid = threadIdx.x;
    int cur = -1;
    for (int it = bid; it < 52 + 64 + 80 + 64; it += nblk) {
        int which, n0; const float* W; int ldw; float* out;
        if (it < 52) { which = 0; n0 = it * 64; W = w_in0; ldw = NIN0; out = (float*)(p.ws + WS_SHW0); }
        else if (it < 116) { which = 1; n0 = (it - 52) * 64; W = w1; ldw = NHID; out = (float*)(p.ws + WS_SHW1); }
        else if (it < 196) { which = 2; n0 = (it - 116) * 64; W = w_in1; ldw = NIN1; out = (float*)(p.ws + WS_SHW2); }
        else { which = 3; n0 = (it - 196) * 64; W = w1 + (size_t)1024 * NHID; ldw = NHID; out = (float*)(p.ws + WS_SHW3); }
        if (which != cur) { __syncthreads(); const int l = which >> 1, off = (which & 1) ? 3 * 1024 : 0;
            for (int i = tid; i < 5 * 1024; i += 512) { const int mb = i >> 10, k = i & 1023; s[i] = mod[(size_t)(l * 5 + mb) * 6144 + off + k]; }
            __syncthreads(); cur = which; }
        gemv5_item(W, ldw, n0, s, red, out, ldw, nullptr);
    }
    __syncthreads();
}
__device__ __forceinline__ void ph_norm_in(const MP& p, int bid, int nblk) {
    const float* x = p.in[0]; const float* ctx = p.in[2]; const float* ng = p.in[4]; const float* mod = (const float*)(p.ws + WS_MOD);
    bf16_t* xb = (bf16_t*)(p.ws + WS_BUF0); float* ssq = (float*)(p.ws + WS_SSQ);
    const int w = threadIdx.x >> 6, lane = threadIdx.x & 63;
    for (int row = bid * 8 + w; row < MALL; row += nblk * 8) {
        const float* xr = row < MLAT ? x + (size_t)row * DM : ctx + (size_t)(row - MLAT) * DM;
        const int mb = row < MLAT ? row >> 13 : 4;
        const f32x4* x4 = (const f32x4*)xr + lane; const f32x4* g4 = (const f32x4*)ng + lane; const f32x4* s4 = (const f32x4*)(mod + (size_t)mb * 6144 + 1024) + lane;
        f32x4 v[4]; float s = 0.f;
#pragma unroll
        for (int j = 0; j < 4; ++j) { v[j] = x4[64 * j]; s += (v[j].x * v[j].x + v[j].y * v[j].y) + (v[j].z * v[j].z + v[j].w * v[j].w); }
        s = wave_sum(s);
        u32x2* o = (u32x2*)(xb + (size_t)row * DM) + lane;
#pragma unroll
        for (int j = 0; j < 4; ++j) { const f32x4 g = g4[64 * j] * (s4[64 * j] + 1.f); u32x2 pk; pk.x = pk2(v[j].x * g.x, v[j].y * g.y); pk.y = pk2(v[j].z * g.z, v[j].w * g.w); o[64 * j] = pk; }
        if (lane < 16) ssq[(size_t)row * 16 + lane] = lane == 0 ? s : 0.f;
    }
}
__device__ __forceinline__ void ph_final(const MP& p, int bid, int nblk) {
    float* out = p.out; const float* ssq = (const float*)(p.ws + WS_SSQ); const float* g = p.in[29];
    const int w = threadIdx.x >> 6, lane = threadIdx.x & 63;
    for (int row = bid * 8 + w; row < MLAT; row += nblk * 8) {
        float s = lane < 16 ? ssq[(size_t)row * 16 + lane] : 0.f; s = wave_sum(s);
        const float rstd = rsqrtf(s * (1.f / 1024.f) + NORM_EPS);
        f32x4* o4 = (f32x4*)(out + (size_t)row * DM) + lane; const f32x4* g4 = (const f32x4*)g + lane;
#pragma unroll
        for (int j = 0; j < 4; ++j) { f32x4 v = o4[64 * j]; const f32x4 gg = g4[64 * j]; v = v * rstd * gg; o4[64 * j] = v; }
    }
}

__device__ __forceinline__ RwkvW mk_rwkvw(const MP& p) {
    RwkvW W; W.mu_prev = p.in[12]; W.mu_next = p.in[13]; W.w0 = p.in[14]; W.w_up = p.in[15]; W.a0 = p.in[16]; W.a_up = p.in[17]; W.g_up = p.in[18]; W.k_k = p.in[19]; W.k_a = p.in[20]; W.r_k = p.in[21]; W.ln_g = p.in[22]; W.ln_b = p.in[23]; return W; }
__device__ __forceinline__ RwkvTmp mk_rwkvtmp(const MP& p) {
    const size_t RH = (size_t)2 * (TL + LC), AB = RH * 512 * 2, AF = RH * 512 * 4;
    char* t0 = (char*)p.out; char* t1 = p.ws + WS_BIG + BIG_P0END;
    RwkvTmp T; T.lw0 = (float*)t0; T.lw1 = (float*)(t0 + AF); T.osum = (float*)(t0 + 2 * AF); T.r = (bf16_t*)(t0 + 3 * AF);
    T.k = (bf16_t*)t1; T.v = (bf16_t*)(t1 + AB); T.kk = (bf16_t*)(t1 + 2 * AB); T.a0 = (bf16_t*)(t1 + 3 * AB); T.a1 = (bf16_t*)(t1 + 4 * AB); T.g = (bf16_t*)(t1 + 5 * AB); return T; }
constexpr int PREP_TOK = 8;
__device__ __forceinline__ void ph_rwkv_prep(const MP& p, int bid, int nblk, char* lds, int b0) {
    const int nbh = 2; const bf16_t* p0 = (const bf16_t*)(p.ws + WS_BIG); const RwkvW W = mk_rwkvw(p); const RwkvTmp T = mk_rwkvtmp(p); float* bc = (float*)(p.ws + WS_BC);
    float (*lin)[256] = (float (*)[256])lds;
    const int tid = threadIdx.x, lane = tid & 63;
    const int nrows = nbh * (TL + LC);
    { f32x4* z = (f32x4*)T.osum; const size_t n4 = (size_t)nrows * 512 / 4; for (size_t i = (size_t)bid * 512 + tid; i < n4; i += (size_t)nblk * 512) z[i] = (f32x4){0.f, 0.f, 0.f, 0.f}; }
    for (int base = bid * PREP_TOK; base < nrows; base += nblk * PREP_TOK) {
        __syncthreads();
        if (tid < 256) { const int col = 1536 + tid; const float mup = W.mu_prev[col], mun = W.mu_next[col];
#pragma unroll
            for (int tk = 0; tk < PREP_TOK; ++tk) { int grow, t, slen; lrow_info(base + tk, b0, nbh, grow, t, slen);
                const float x = shifted(p0, grow, t, slen, col, mup, mun);
                lin[tk][tid] = tid < 64 ? tanhf(x) : (tid < 128 ? x : sigmoidf_(x)); } }
        __syncthreads();
        { const int c = tid;
            float wl0[PREP_TOK], wl1[PREP_TOK], av0[PREP_TOK], av1[PREP_TOK], gv[PREP_TOK];
#pragma unroll
            for (int tk = 0; tk < PREP_TOK; ++tk) { wl0[tk] = W.w0[c]; wl1[tk] = W.w0[512 + c]; av0[tk] = W.a0[c]; av1[tk] = W.a0[512 + c]; gv[tk] = 0.f; }
#pragma unroll 4
            for (int j = 0; j < 64; ++j) { const float u0 = W.w_up[(size_t)j * 512 + c], u1 = W.w_up[(size_t)(64 + j) * 512 + c], q0 = W.a_up[(size_t)j * 512 + c], q1 = W.a_up[(size_t)(64 + j) * 512 + c];
#pragma unroll
                for (int tk = 0; tk < PREP_TOK; ++tk) { const float tl = lin[tk][j], al = lin[tk][64 + j]; wl0[tk] += tl * u0; wl1[tk] += tl * u1; av0[tk] += al * q0; av1[tk] += al * q1; } }
#pragma unroll 4
            for (int j = 0; j < 128; ++j) { const float gu = W.g_up[(size_t)j * 512 + c];
#pragma unroll
                for (int tk = 0; tk < PREP_TOK; ++tk) gv[tk] += lin[tk][128 + j] * gu; }
            const float mpr = W.mu_prev[c], mnr = W.mu_next[c], mpk = W.mu_prev[512 + c], mnk = W.mu_next[512 + c], mpv = W.mu_prev[1024 + c], mnv = W.mu_next[1024 + c];
            const float kkc = W.k_k[c], kac = W.k_a[c], rkc = W.r_k[c];
#pragma unroll
            for (int tk = 0; tk < PREP_TOK; ++tk) { int grow, t, slen; lrow_info(base + tk, b0, nbh, grow, t, slen);
                const float r = shifted(p0, grow, t, slen, c, mpr, mnr), k = shifted(p0, grow, t, slen, 512 + c, mpk, mnk), v = shifted(p0, grow, t, slen, 1024 + c, mpv, mnv);
                const float sp0 = wl0[tk] > 15.f ? 0.f : log1pf(__expf(-wl0[tk])), sp1 = wl1[tk] > 15.f ? 0.f : log1pf(__expf(-wl1[tk]));
                const float lw0 = -__expf(-(wl0[tk] < -15.f ? -wl0[tk] : sp0) - 0.5f), lw1 = -__expf(-(wl1[tk] < -15.f ? -wl1[tk] : sp1) - 0.5f);
                const float a0 = sigmoidf_(av0[tk]), a1 = sigmoidf_(av1[tk]);
                float kk = k * kkc; const float n2 = wave_sum(kk * kk); kk = kk / fmaxf(sqrtf(n2), 1e-12f);
                const float kd0 = k * (1.f + (a0 - 1.f) * kac), kd1 = k * (1.f + (a1 - 1.f) * kac);
                const float bsum = wave_sum(r * rkc * (kd0 + kd1));
                const size_t o = (size_t)(base + tk) * 512 + c;
                T.r[o] = f2bf(r); T.k[o] = f2bf(k); T.v[o] = f2bf(v); T.kk[o] = f2bf(kk); T.a0[o] = f2bf(a0); T.a1[o] = f2bf(a1); T.g[o] = f2bf(gv[tk]); T.lw0[o] = lw0; T.lw1[o] = lw1;
                if (lane == 0) bc[(size_t)grow * 8 + (c >> 6)] = bsum; }
        }
    }
    __syncthreads();
}
__device__ __forceinline__ void ph_rwkv_scan(const MP& p, int bid) {
    const int nbh = 2; const RwkvTmp T = mk_rwkvtmp(p); const float* k_a = p.in[20];
    const int chain = bid * 2 + (threadIdx.x >> 8), dir = chain / (nbh * 8), lb = (chain / 8) % nbh, h = chain & 7;
    const int tid = threadIdx.x & 255, v = tid >> 2, kq = tid & 3;
    float S[16], ka[16];
#pragma unroll
    for (int i = 0; i < 16; ++i) { S[i] = 0.f; ka[i] = k_a[h * 64 + kq * 16 + i]; }
    const int nsteps = LC + TL;
    auto lrow_of = [&](int s) -> size_t { if (s < LC) { const int t = dir ? LC - 1 - s : s; return (size_t)nbh * TL + lb * LC + t; } const int s2 = s - LC; const int t = dir ? TL - 1 - s2 : s2; return (size_t)lb * TL + t; };
    ScanIn cur, nxt; scan_load(cur, T, dir, lrow_of(0), h, v, kq);
    for (int s = 0; s < nsteps; ++s) {
        const size_t lrow = lrow_of(s);
        if (s + 1 < nsteps) scan_load(nxt, T, dir, lrow_of(s + 1), h, v, kq); else nxt = cur;
        float r[16], k[16], kk[16], a[16], w[16];
#pragma unroll
        for (int i = 0; i < 16; ++i) { const int q = i >> 3, j = (i >> 1) & 3, hi = i & 1; r[i] = bfu(cur.r[q][j], hi); k[i] = bfu(cur.k[q][j], hi); kk[i] = bfu(cur.kk[q][j], hi); a[i] = bfu(cur.a[q][j], hi); w[i] = __expf(cur.lw[i >> 2][i & 3]); }
        float skk = 0.f;
#pragma unroll
        for (int i = 0; i < 16; ++i) skk += S[i] * kk[i];
        skk += __shfl_xor(skk, 1); skk += __shfl_xor(skk, 2);
        float o = 0.f;
#pragma unroll
        for (int i = 0; i < 16; ++i) { const float kd = k[i] * (1.f + (a[i] - 1.f) * ka[i]); S[i] = S[i] * w[i] - skk * (kk[i] * a[i]) + cur.v * kd; o += S[i] * r[i]; }
        o += __shfl_xor(o, 1); o += __shfl_xor(o, 2);
        if (kq == 0) atomicAdd(T.osum + lrow * 512 + h * 64 + v, o);
        cur = nxt;
    }
}
__device__ __forceinline__ void ph_rwkv_post(const MP& p, int bid, int nblk, int b0) {
    const int nbh = 2; const RwkvTmp T = mk_rwkvtmp(p); const float* bc = (const float*)(p.ws + WS_BC); const float* ln_g = p.in[22]; const float* ln_b = p.in[23]; bf16_t* mix = (bf16_t*)(p.ws + WS_BUF0);
    const int w = threadIdx.x >> 6, lane = threadIdx.x & 63; const int nrows = nbh * (TL + LC);
    for (int lr = bid * 8 + w; lr < nrows; lr += nblk * 8) { int grow, t, slen; lrow_info(lr, b0, nbh, grow, t, slen);
        const float* op = T.osum + (size_t)lr * 512 + lane * 8; float o[8]; float s = 0.f;
#pragma unroll
        for (int i = 0; i < 8; ++i) { o[i] = op[i]; s += o[i]; }
        s += __shfl_xor(s, 1); s += __shfl_xor(s, 2); s += __shfl_xor(s, 4); const float mu = s * (1.f / 64.f); float q = 0.f;
#pragma unroll
        for (int i = 0; i < 8; ++i) { const float d = o[i] - mu; q += d * d; }
        q += __shfl_xor(q, 1); q += __shfl_xor(q, 2); q += __shfl_xor(q, 4); const float rs = rsqrtf(q * (1.f / 64.f) + 64e-5f);
        const float bcv = bc[(size_t)grow * 8 + (lane >> 3)]; unsigned pk[4];
#pragma unroll
        for (int i = 0; i < 8; i += 2) { float y[2];
#pragma unroll
            for (int e = 0; e < 2; ++e) { const int c = lane * 8 + i + e; const float vv = bf2f(T.v[(size_t)lr * 512 + c]), gg = bf2f(T.g[(size_t)lr * 512 + c]);
                y[e] = ((o[i + e] - mu) * rs * ln_g[c] + ln_b[c] + bcv * vv) * gg; }
            pk[i >> 1] = pk2(y[0], y[1]); }
        u32x4 st; st.x = pk[0]; st.y = pk[1]; st.z = pk[2]; st.w = pk[3];
        *(u32x4*)(mix + (size_t)grow * DM + lane * 8) = st;
    }
}

__device__ __forceinline__ void ph_na(const MP& p, int bid, int nblk, char* lds, int t_lo, int t_hi) {
    const bf16_t* p0 = (const bf16_t*)(p.ws + WS_BIG); const float* rpb = p.in[24]; bf16_t* mix = (bf16_t*)(p.ws + WS_BUF0);
    float (*pbuf)[384] = (float (*)[384])lds;
    const int w = threadIdx.x >> 6, lane = threadIdx.x & 63;
    for (int task = t_lo + bid * 8 + w; task < t_hi; task += nblk * 8) {
        const int grow = task >> 3, h = task & 7;
        const bool lat = grow < MLAT;
        const int b = lat ? grow >> 13 : (grow - MLAT) >> 8;
        const int tq = lat ? grow & 8191 : 0, rq = tq >> 6, cq = tq & 63;
        const int r0 = min(max(rq - 4, 0), 120), c0 = min(max(cq - 8, 0), 48);
        const int nkeys = lat ? 384 : 256;
        float q[64];
        { const u32x4* qp = (const u32x4*)(p0 + (size_t)grow * NIN0 + 1792 + h * 64);
#pragma unroll
          for (int i = 0; i < 8; ++i) { const u32x4 x = qp[i];
#pragma unroll
              for (int j = 0; j < 4; ++j) { q[i * 8 + 2 * j] = bfu(x[j], 0); q[i * 8 + 2 * j + 1] = bfu(x[j], 1); } } }
        float sc[6]; float mx = -1e30f;
#pragma unroll
        for (int jj = 0; jj < 6; ++jj) { const int j = jj * 64 + lane; sc[jj] = -1e30f;
            if (j < nkeys) { int krow; float bias = 0.f;
                if (lat && j < 128) { const int kr = j >> 4, kc = j & 15; krow = b * TL + (r0 + kr) * 64 + c0 + kc; bias = rpb[(h * 15 + (r0 + kr - rq + 7)) * 31 + (c0 + kc - cq + 15)]; }
                else { const int l = lat ? j - 128 : j; krow = MLAT + b * LC + l; }
                const u32x4* kp = (const u32x4*)(p0 + (size_t)krow * NIN0 + 2304 + h * 64); float d = 0.f;
#pragma unroll
                for (int i = 0; i < 8; ++i) { const u32x4 x = kp[i];
#pragma unroll
                    for (int jx = 0; jx < 4; ++jx) d += q[i * 8 + 2 * jx] * bfu(x[jx], 0) + q[i * 8 + 2 * jx + 1] * bfu(x[jx], 1); }
                sc[jj] = d * 0.125f + bias; }
            mx = fmaxf(mx, sc[jj]); }
#pragma unroll
        for (int o = 1; o < 64; o <<= 1) mx = fmaxf(mx, __shfl_xor(mx, o));
        float sum = 0.f;
#pragma unroll
        for (int jj = 0; jj < 6; ++jj) { const int j = jj * 64 + lane; const float pv = j < nkeys ? __expf(sc[jj] - mx) : 0.f; sum += pv; if (j < 384) pbuf[w][j] = pv; }
        sum = wave_sum(sum);
        __builtin_amdgcn_s_waitcnt(0xc07f); asm volatile("" ::: "memory");
        float acc = 0.f;
        for (int j = 0; j < nkeys; ++j) { int krow;
            if (lat && j < 128) { const int kr = j >> 4, kc = j & 15; krow = b * TL + (r0 + kr) * 64 + c0 + kc; }
            else { const int l = lat ? j - 128 : j; krow = MLAT + b * LC + l; }
            acc += pbuf[w][j] * bf2f(p0[(size_t)krow * NIN0 + 2816 + h * 64 + lane]); }
        mix[(size_t)grow * DM + 512 + h * 64 + lane] = f2bf(acc / sum);
        __builtin_amdgcn_s_waitcnt(0xc07f); asm volatile("" ::: "memory");
    }
}

__device__ __forceinline__ void ph_hgrn_scan(const MP& p, int bid, int dir) {
    const bf16_t* p1 = (const bf16_t*)(p.ws + WS_BIG); const float* lbv = (const float*)(p.ws + WS_LB); bf16_t* obuf = (bf16_t*)(p.ws + WS_BUF0);
    const int b = bid >> 3, h = bid & 7; const int tid = threadIdx.x, v = tid >> 2, kq = tid & 3;
    float S[32], lb[32];
#pragma unroll
    for (int i = 0; i < 32; ++i) { S[i] = 0.f; lb[i] = lbv[h * 128 + kq * 32 + i]; }
    const int nsteps = LC + TL; const int fcol = (dir ? 2048 : 1024) + h * 128 + kq * 32, qcol = h * 128 + kq * 32, icol = 3072 + h * 128 + v;
    auto grow_of = [&](int s) -> size_t { if (s < LC) { const int t = dir ? LC - 1 - s : s; return (size_t)MLAT + b * LC + t; } const int s2 = s - LC; const int t = dir ? TL - 1 - s2 : s2; return (size_t)b * TL + t; };
    u32x4 fq_[4], qq_[4], nf_[4], nq_[4]; float iv, niv;
    { const size_t g0 = grow_of(0); const u32x4* fp = (const u32x4*)(p1 + g0 * NIN1 + fcol); const u32x4* qp = (const u32x4*)(p1 + g0 * NIN1 + qcol);
#pragma unroll
      for (int i = 0; i < 4; ++i) { fq_[i] = fp[i]; qq_[i] = qp[i]; nf_[i] = fp[i]; nq_[i] = qp[i]; } iv = bf2f(p1[g0 * NIN1 + icol]); niv = iv; }
    for (int s = 0; s < nsteps; ++s) {
        const size_t grow = grow_of(s);
        if (s + 1 < nsteps) { const size_t g1 = grow_of(s + 1); const u32x4* fp = (const u32x4*)(p1 + g1 * NIN1 + fcol); const u32x4* qp = (const u32x4*)(p1 + g1 * NIN1 + qcol);
#pragma unroll
            for (int i = 0; i < 4; ++i) { nf_[i] = fp[i]; nq_[i] = qp[i]; } niv = bf2f(p1[g1 * NIN1 + icol]); }
        float o = 0.f;
#pragma unroll
        for (int i = 0; i < 32; ++i) { const float f = bfu(fq_[i >> 3][(i >> 1) & 3], i & 1), qv = bfu(qq_[i >> 3][(i >> 1) & 3], i & 1);
            const float fg = lb[i] + (1.f - lb[i]) * sigmoidf_(f); S[i] = fg * S[i] + (1.f - fg) * iv; o += S[i] * qv; }
        o += __shfl_xor(o, 1); o += __shfl_xor(o, 2);
        if (kq == 0 && s >= LC) { bf16_t* op = obuf + grow * DM + h * 128 + v; *op = dir ? f2bf(o + bf2f(*op)) : f2bf(o); }
#pragma unroll
        for (int i = 0; i < 4; ++i) { fq_[i] = nf_[i]; qq_[i] = nq_[i]; } iv = niv;
    }
}
__device__ __forceinline__ void ph_hgrn_out(const MP& p, int bid, int nblk) {
    bf16_t* obuf = (bf16_t*)(p.ws + WS_BUF0); const bf16_t* p1 = (const bf16_t*)(p.ws + WS_BIG); const float* g = p.in[28];
    const int w = threadIdx.x >> 6, lane = threadIdx.x & 63;
    for (int row = bid * 8 + w; row < MLAT; row += nblk * 8) {
        bf16_t* op = obuf + (size_t)row * DM + lane * 16; const bf16_t* gp = p1 + (size_t)row * NIN1 + 4096 + lane * 16;
        float o[16]; float s = 0.f;
#pragma unroll
        for (int i = 0; i < 16; ++i) { o[i] = bf2f(op[i]); s += o[i] * o[i]; }
        s = wave_sum(s); const float rs = rsqrtf(s * (1.f / 1024.f) + NORM_EPS);
#pragma unroll
        for (int i = 0; i < 16; ++i) op[i] = f2bf(o[i] * rs * g[lane * 16 + i] * siluf_(bf2f(gp[i])));
    }
}

template <int ACT> __device__ __forceinline__ void ph_gemm_act(LAS unsigned char* lds, const bf16_t* A, const bf16_t* Bt, int M, int N, int K, bf16_t* O, const float* ssq, const float* shw, int G, int bid) {
    pg8::Gemm g; g.A = A; g.Bt = Bt; g.M = M; g.N = N; g.K = K; pg8::StaticOrder S; S.init(M, N, G, bid);
    pg8::EpiAct<ACT> E; E.O = O; E.ldc = N; E.ssq = ssq; E.shw = shw; E.ncol = N;
    pg8::gemm_phase<pg8::EpiAct<ACT>, pg8::StaticOrder, true, true>(lds, g, S, E);
}
template <bool HB> __device__ __forceinline__ void ph_gemm_res(LAS unsigned char* lds, const bf16_t* A, const bf16_t* Bt, int M, int K, const float* hin_lat, const float* hin_ctx, float* hout_lat, float* hout_ctx,
                                                              const float* gate, const float* gsn, bf16_t* hb, float* ssq, int G, int bid) {
    pg8::Gemm g; g.A = A; g.Bt = Bt; g.M = M; g.N = DM; g.K = K; pg8::StaticOrder S; S.init(M, DM, G, bid);
    pg8::EpiRes<HB> E; E.hin_lat = hin_lat; E.hin_ctx = hin_ctx; E.hout_lat = hout_lat; E.hout_ctx = hout_ctx; E.gate = gate; E.gsn = gsn; E.hb = hb; E.ssq = ssq;
    pg8::gemm_phase<pg8::EpiRes<HB>, pg8::StaticOrder, true, true>(lds, g, S, E);
}

constexpr int NPHASE = 20;
__global__ void __launch_bounds__(NTHREADS, 2) mega(MP p) {
    extern __shared__ __attribute__((aligned(16))) unsigned char lds_raw[];
    LAS unsigned char* lds = (LAS unsigned char*)lds_raw;
    char* ldsg = (char*)lds_raw;
    const int tid = threadIdx.x;
    const int G = gridDim.x, bid = blockIdx.x;
    volatile LAS unsigned* MISC = (volatile LAS unsigned*)(lds + MISC_OFF);
    for (int u = tid; u < (LDS_BYTES - LDSCTL_OFF) / 4; u += NTHREADS) ((LAS unsigned*)(lds + LDSCTL_OFF))[u] = 0u;
    __syncthreads();
    unsigned* ctl = (unsigned*)(p.ws + WS_CTL);
    const bool multi = (p.ph_hi - p.ph_lo) > 1;
    XcdBarrier bar; bar.bar = ctl + CW_BAR; bar.x = 0; bar.st = nullptr;
    if (multi) bar = xcd_barrier_post(ctl + CW_BAR, MISC + 8);
    const int lo = p.ph_lo, hi = p.ph_hi;
#define IN(k) (lo <= (k) && (k) < hi)
#define SEAM(k) do { if (IN(k) && IN((k) + 1)) xcd_barrier(bar); } while (0)
    char* ws = p.ws; float* out = p.out;
    const float* mod = (const float*)(ws + WS_MOD); const float* gs = (const float*)(ws + WS_GS); float* ssq = (float*)(ws + WS_SSQ); float* hctx = (float*)(ws + WS_HCTX);
    bf16_t* buf0 = (bf16_t*)(ws + WS_BUF0); bf16_t* big = (bf16_t*)(ws + WS_BIG); bf16_t* hbs = (bf16_t*)(ws + WS_BIG + BIG_HB);
    const float* mod1 = mod + (size_t)5 * 6144;
#define WTP(off) ((const bf16_t*)(ws + WS_WT + (off)))
    constexpr int NA_TASKS = MALL * 8, NA_HALF = NA_TASKS / 2;

    if (IN(0)) { ph_adaln(p, bid, G, ldsg); ph_wt(p, bid, G, ldsg); } SEAM(0);
    if (IN(1)) { ph_gs(p, bid, G); ph_shw(p, bid, G, ldsg); ph_norm_in(p, bid, G); } SEAM(1);
    if (IN(2)) ph_gemm_act<0>(lds, buf0, WTP(WT_IN0), MALL, NIN0, DM, big, ssq, (const float*)(ws + WS_SHW0), G, bid); SEAM(2);
    if (IN(3)) ph_rwkv_prep(p, bid, G, ldsg, 0); SEAM(3);
    if (IN(4)) { if (bid < 16) ph_rwkv_scan(p, bid); else ph_na(p, bid - 16, G - 16, ldsg, 0, NA_HALF); } SEAM(4);
    if (IN(5)) ph_rwkv_post(p, bid, G, 0); SEAM(5);
    if (IN(6)) ph_rwkv_prep(p, bid, G, ldsg, 2); SEAM(6);
    if (IN(7)) { if (bid < 16) ph_rwkv_scan(p, bid); else ph_na(p, bid - 16, G - 16, ldsg, NA_HALF, NA_TASKS); } SEAM(7);
    if (IN(8)) ph_rwkv_post(p, bid, G, 2); SEAM(8);
    if (IN(9)) ph_gemm_res<true>(lds, buf0, WTP(WT_OUT0), MALL, DM, p.in[0], p.in[2], out, hctx, mod + 2 * 1024, gs + 1 * 5 * 1024, hbs, ssq, G, bid); SEAM(9);
    if (IN(10)) ph_gemm_act<1>(lds, hbs, WTP(WT_W10), MALL, NHID, DM, big, ssq, (const float*)(ws + WS_SHW1), G, bid); SEAM(10);
    if (IN(11)) ph_gemm_res<true>(lds, big, WTP(WT_W20), MALL, NHID, out, hctx, out, hctx, mod + 5 * 1024, gs + 2 * 5 * 1024, buf0, ssq, G, bid); SEAM(11);
    if (IN(12)) ph_gemm_act<2>(lds, buf0, WTP(WT_IN1), MALL, NIN1, DM, big, ssq, (const float*)(ws + WS_SHW2), G, bid); SEAM(12);
    if (IN(13)) { if (bid < 32) ph_hgrn_scan(p, bid, 0); } SEAM(13);
    if (IN(14)) { if (bid < 32) ph_hgrn_scan(p, bid, 1); } SEAM(14);
    if (IN(15)) ph_hgrn_out(p, bid, G); SEAM(15);
    if (IN(16)) ph_gemm_res<true>(lds, buf0, WTP(WT_OUT1), MLAT, DM, out, hctx, out, hctx, mod1 + 2 * 1024, gs + 3 * 5 * 1024, hbs, ssq, G, bid); SEAM(16);
    if (IN(17)) ph_gemm_act<1>(lds, hbs, WTP(WT_W11), MLAT, NHID, DM, big, ssq, (const float*)(ws + WS_SHW3), G, bid); SEAM(17);
    if (IN(18)) ph_gemm_res<false>(lds, big, WTP(WT_W21), MLAT, NHID, out, hctx, out, hctx, mod1 + 5 * 1024, nullptr, nullptr, ssq, G, bid); SEAM(18);
    if (IN(19)) ph_final(p, bid, G);
#undef IN
#undef SEAM
#undef WTP
}

#ifndef MK_N_LAUNCHES
#define MK_N_LAUNCHES 1
#endif
extern "C" void kernel_launch(void* const* d_in, const int* in_sizes, int n_in, void* d_out, int out_size, void* d_ws, size_t ws_size, hipStream_t stream) {
    static int grid = 0;
    if (grid == 0) {
        if (n_in != 30 || ws_size < WS_END) { fprintf(stderr, "kernel_launch: bad inputs (n_in %d, ws %zu < %zu)\n", n_in, ws_size, (size_t)WS_END); grid = -1; return; }
        int dev = 0, cus = 0, per_cu = 0;
        if (hipGetDevice(&dev) != hipSuccess || hipDeviceGetAttribute(&cus, hipDeviceAttributeMultiprocessorCount, dev) != hipSuccess) { grid = -1; return; }
        if (hipFuncSetAttribute((const void*)mega, hipFuncAttributeMaxDynamicSharedMemorySize, LDS_BYTES) != hipSuccess) { fprintf(stderr, "kernel_launch: hipFuncSetAttribute failed\n"); grid = -1; return; }
        if (hipOccupancyMaxActiveBlocksPerMultiprocessor(&per_cu, (const void*)mega, NTHREADS, LDS_BYTES) != hipSuccess || per_cu < 1) { fprintf(stderr, "kernel_launch: occupancy query says %d\n", per_cu); per_cu = 1; }
        (void)hipGetLastError();
        grid = cus;
    }
    if (grid < 0) return;
    (void)hipMemsetAsync((char*)d_ws + WS_CTL, 0, CTL_ZERO_BYTES, stream);
    MP a; memset((void*)&a, 0, sizeof(a));
    for (int i = 0; i < 30; ++i) a.in[i] = (const float*)d_in[i];
    a.out = (float*)d_out; a.ws = (char*)d_ws;
#if MK_N_LAUNCHES == 1
    a.ph_lo = 0; a.ph_hi = NPHASE;
    hipLaunchKernelGGL(mega, dim3(grid), dim3(NTHREADS), LDS_BYTES, stream, a);
#else
    for (int ph = 0; ph < NPHASE; ++ph) { a.ph_lo = ph; a.ph_hi = ph + 1; hipLaunchKernelGGL(mega, dim3(grid), dim3(NTHREADS), LDS_BYTES, stream, a); }
#endif
}
```

```cpp
#include <hip/hip_runtime.h>
#include <cstdio>
#include <cstdint>
#include <cstring>
namespace pg8 {
#define PG8_LAS __attribute__((address_space(3)))
typedef unsigned short bf16_t;
typedef short bf16x8 __attribute__((ext_vector_type(8)));
typedef float f32x4 __attribute__((ext_vector_type(4)));
typedef unsigned u32x4 __attribute__((ext_vector_type(4)));
constexpr int BM = 256, BK = 64, HALF = 128, HTB = HALF * BK * 2  , STAGE_BYTES = 8 * HTB, NXCD = 8, WGM = 8;

__host__ __device__ __forceinline__ int lds_byte(int r, int c) { const int st = (r >> 4) * 2 + (c >> 5), rr = r & 15, cc = c & 31, ob = rr * 64 + cc * 2; return st * 1024 + (ob ^ (((ob >> 9) & 1) << 5)); }
__host__ __device__ __forceinline__ void stage_rc(int b, int& R, int& C) { const int st = b / 1024, sb = b % 1024, swz = sb ^ (((sb >> 9) & 1) << 5); R = (st >> 1) * 16 + swz / 64; C = (st & 1) * 32 + (swz % 64) / 2; }
__host__ __device__ __forceinline__ int perm32(int rho) { const int n = rho >> 4, i = rho & 15; return 8 * (i >> 2) + 4 * n + (i & 3); }

struct Unit { int pm, pn; };
struct Gemm { const bf16_t* A; const bf16_t* Bt; int M, N, K; };

struct StaticOrder {
    int nM, nN, nwg, G, c;
    __host__ __device__ void init(int M, int N, int G_, int c_) { nM = M / BM; nN = N / BM; nwg = nM * nN; G = G_; c = c_; }
    __host__ __device__ bool next(int i, Unit& u) const {
        const long L = (long)i * G + c; if (L >= nwg) return false;
        int wgid = (int)L; { const int q = nwg / NXCD, r = nwg % NXCD, xcd = wgid % NXCD, off = wgid / NXCD; wgid = (xcd < r ? xcd * (q + 1) : r * (q + 1) + (xcd - r) * q) + off; }
        const int nig = WGM * nN, gid = wgid / nig, fm = gid * WGM, gsz = (nM - fm) < WGM ? (nM - fm) : WGM;
        u.pm = fm + ((wgid % nig) % gsz); u.pn = (wgid % nig) / gsz; return true;
    }
    __device__ __forceinline__ void a_ready(const Unit&) const {}
    __device__ __forceinline__ void done(const Unit&) const {}
};
typedef float f32x2_t __attribute__((ext_vector_type(2))); typedef __bf16 bf16x2_t __attribute__((ext_vector_type(2)));
__device__ __forceinline__ unsigned cvt_pk_bf16(float lo, float hi) { f32x2_t v = {lo, hi}; bf16x2_t b = __builtin_convertvector(v, bf16x2_t); return __builtin_bit_cast(unsigned, b); }
template <class Epi, class Sched, bool ALIGN_EPI = false, bool SP2 = false>
__device__ __forceinline__ void gemm_phase(PG8_LAS unsigned char* lds, const Gemm g, const Sched& S, const Epi& E) {
    const int tid = threadIdx.x, wid = __builtin_amdgcn_readfirstlane(tid >> 6), lane = tid & 63, wr = wid >> 2, wc = wid & 3, fr = lane & 15, fq = lane >> 4;
    const int K = g.K, nt = K / BK;
    unsigned voffA[2], voffB[2];
#pragma unroll
    for (int i = 0; i < 2; ++i) { int R, C; stage_rc(tid * 16 + i * 8192, R, C); const int Rb = Epi::PERM ? ((R & ~31) + perm32(R & 31)) : R;
        voffA[i] = (unsigned)(R * K + C) * 2u; voffB[i] = (unsigned)(Rb * K + C) * 2u; }
    const size_t kstep = (size_t)(BK * 2);
    const size_t hstep = (size_t)HALF * K * 2;
    const size_t tstep = 2 * hstep;
    const unsigned ldsw = (unsigned)wid * 1024u;
    const int aoff = lds_byte(wr * 64 + fr, fq * 8), boff = lds_byte(wc * 32 + fr, fq * 8);
#define PG8_SA(b, h) (((b) * 2 + (h)) * HTB)
#define PG8_SB(b, h) ((4 + (b) * 2 + (h)) * HTB)
#define PG8_STAGE(bufoff, gbase, voff) do { _Pragma("unroll") for (int _i = 0; _i < 2; ++_i) \
        __builtin_amdgcn_global_load_lds((const unsigned*)((const char*)(gbase) + (voff)[_i]), (PG8_LAS unsigned*)(lds + (bufoff) + ldsw + _i * 8192), 16, 0, 0); } while (0)
#define PG8_LDA(dst, b, h) do { _Pragma("unroll") for (int m = 0; m < 4; ++m) _Pragma("unroll") for (int k = 0; k < 2; ++k) dst[m][k] = *(const PG8_LAS bf16x8*)(lds + PG8_SA(b, h) + aoff + m * 2048 + k * 1024); } while (0)
#define PG8_LDB(dst, b, h) do { _Pragma("unroll") for (int n = 0; n < 2; ++n) _Pragma("unroll") for (int k = 0; k < 2; ++k) dst[n][k] = *(const PG8_LAS bf16x8*)(lds + PG8_SB(b, h) + boff + n * 2048 + k * 1024); } while (0)
#define PG8_MMA(ai, bj, At, Bt) do { __builtin_amdgcn_s_setprio(1); _Pragma("unroll") for (int m = 0; m < 4; ++m) _Pragma("unroll") for (int n = 0; n < 2; ++n) _Pragma("unroll") for (int k = 0; k < 2; ++k) \
        acc[ai][bj][m][n] = __builtin_amdgcn_mfma_f32_16x16x32_bf16(Bt[n][k], At[m][k], acc[ai][bj][m][n], 0, 0, 0); __builtin_amdgcn_s_setprio(0); } while (0)
#define PG8_WAIT_V(n) asm volatile("s_waitcnt vmcnt(" #n ")" ::: "memory")
#define PG8_WAIT_L(n) asm volatile("s_waitcnt lgkmcnt(" #n ")" ::: "memory")
#define PG8_BAR __builtin_amdgcn_s_barrier()
#define PG8_SCHED __builtin_amdgcn_sched_barrier(0)
    Unit cur, nxt; int ui = 0;
    if (!S.next(0, cur)) return;
    f32x4 acc[2][2][4][2];
#pragma unroll
    for (int a = 0; a < 2; ++a)
#pragma unroll
        for (int b = 0; b < 2; ++b)
#pragma unroll
            for (int m = 0; m < 4; ++m)
#pragma unroll
                for (int n = 0; n < 2; ++n) acc[a][b][m][n] = (f32x4){0.f, 0.f, 0.f, 0.f};
    bf16x8 At[4][2], B0[2][2], B1[2][2];
    const char* cA = (const char*)g.A + (size_t)cur.pm * tstep; const char* cB = (const char*)g.Bt + (size_t)cur.pn * tstep;
    S.a_ready(cur);
    if constexpr (SP2) {
        PG8_STAGE(PG8_SB(0, 0), cB, voffB); PG8_STAGE(PG8_SB(0, 1), cB + hstep, voffB); PG8_STAGE(PG8_SA(0, 0), cA, voffA); PG8_STAGE(PG8_SA(0, 1), cA + hstep, voffA);
        if (wr == 1) PG8_BAR;
        PG8_WAIT_V(2); PG8_BAR;
        PG8_STAGE(PG8_SB(1, 0), cB + kstep, voffB); PG8_STAGE(PG8_SA(1, 0), cA + kstep, voffA); PG8_STAGE(PG8_SB(1, 1), cB + hstep + kstep, voffB);
        PG8_WAIT_V(6); PG8_BAR;
    } else {
        PG8_STAGE(PG8_SB(0, 0), cB, voffB); PG8_STAGE(PG8_SA(0, 0), cA, voffA); PG8_STAGE(PG8_SB(0, 1), cB + hstep, voffB); PG8_STAGE(PG8_SA(0, 1), cA + hstep, voffA);
        if (wr == 1) PG8_BAR;
        PG8_WAIT_V(4); PG8_BAR;
        PG8_STAGE(PG8_SB(1, 0), cB + kstep, voffB); PG8_STAGE(PG8_SA(1, 0), cA + kstep, voffA); PG8_STAGE(PG8_SB(1, 1), cB + hstep + kstep, voffB);
        PG8_WAIT_V(6); PG8_BAR;
    }
    for (;;) {
        const bool has_next = S.next(ui + 1, nxt);
        const char* nA = has_next ? (const char*)g.A + (size_t)nxt.pm * tstep : cA; const char* nB = has_next ? (const char*)g.Bt + (size_t)nxt.pn * tstep : cB;
        for (int t = 0; t < nt; t += 2) {
            const bool last = (t == nt - 2);
            const char* a1 = cA + (size_t)(t + 1) * kstep;
            const char* a2 = last ? nA : cA + (size_t)(t + 2) * kstep; const char* b2 = last ? nB : cB + (size_t)(t + 2) * kstep;
            const char* a3 = a2 + kstep; const char* b3 = b2 + kstep;
            if (last && has_next) S.a_ready(nxt);
            if constexpr (SP2) {
            PG8_LDB(B0, 0, 0); PG8_LDB(B1, 0, 1); PG8_SCHED; PG8_LDA(At, 0, 0); PG8_STAGE(PG8_SA(1, 1), a1 + hstep, voffA);
            PG8_WAIT_V(8); PG8_WAIT_L(0); PG8_BAR; PG8_MMA(0, 0, At, B0); PG8_MMA(0, 1, At, B1); PG8_BAR; PG8_SCHED;
            PG8_LDA(At, 0, 1); PG8_STAGE(PG8_SB(0, 0), b2, voffB); PG8_STAGE(PG8_SB(0, 1), b2 + hstep, voffB); PG8_STAGE(PG8_SA(0, 0), a2, voffA);
            PG8_WAIT_V(8); PG8_WAIT_L(0); PG8_BAR; PG8_MMA(1, 0, At, B0); PG8_MMA(1, 1, At, B1); PG8_BAR; PG8_SCHED;
            PG8_LDB(B0, 1, 0); PG8_LDB(B1, 1, 1); PG8_SCHED; PG8_LDA(At, 1, 0); PG8_STAGE(PG8_SA(0, 1), a2 + hstep, voffA);
            PG8_WAIT_V(8); PG8_WAIT_L(0); PG8_BAR; PG8_MMA(0, 0, At, B0); PG8_MMA(0, 1, At, B1); PG8_BAR; PG8_SCHED;
            PG8_LDA(At, 1, 1); PG8_STAGE(PG8_SB(1, 0), b3, voffB); PG8_STAGE(PG8_SB(1, 1), b3 + hstep, voffB); PG8_STAGE(PG8_SA(1, 0), a3, voffA);
            PG8_WAIT_V(8); PG8_WAIT_L(0); PG8_BAR; PG8_MMA(1, 0, At, B0); PG8_MMA(1, 1, At, B1); PG8_BAR; PG8_SCHED;
            } else {
            PG8_LDB(B0, 0, 0); PG8_SCHED; PG8_LDA(At, 0, 0); PG8_STAGE(PG8_SA(1, 1), a1 + hstep, voffA);
            PG8_WAIT_L(8); PG8_BAR; PG8_WAIT_L(0); PG8_MMA(0, 0, At, B0); PG8_BAR; PG8_SCHED;
            PG8_LDB(B1, 0, 1); PG8_STAGE(PG8_SB(0, 0), b2, voffB);
            PG8_BAR; PG8_WAIT_L(0); PG8_MMA(0, 1, At, B1); PG8_BAR;
            PG8_LDA(At, 0, 1); PG8_STAGE(PG8_SA(0, 0), a2, voffA);
            PG8_BAR; PG8_WAIT_L(0); PG8_MMA(1, 0, At, B0); PG8_BAR; PG8_SCHED;
            PG8_STAGE(PG8_SB(0, 1), b2 + hstep, voffB);
            PG8_WAIT_V(6); PG8_BAR; PG8_MMA(1, 1, At, B1); PG8_BAR;
            PG8_LDB(B0, 1, 0); PG8_SCHED; PG8_LDA(At, 1, 0); PG8_STAGE(PG8_SA(0, 1), a2 + hstep, voffA);
            PG8_WAIT_L(8); PG8_BAR; PG8_WAIT_L(0); PG8_MMA(0, 0, At, B0); PG8_BAR; PG8_SCHED;
            PG8_LDB(B1, 1, 1); PG8_STAGE(PG8_SB(1, 0), b3, voffB);
            PG8_BAR; PG8_WAIT_L(0); PG8_MMA(0, 1, At, B1); PG8_BAR;
            PG8_LDA(At, 1, 1); PG8_STAGE(PG8_SA(1, 0), a3, voffA);
            PG8_BAR; PG8_WAIT_L(0); PG8_MMA(1, 0, At, B0); PG8_BAR; PG8_SCHED;
            PG8_STAGE(PG8_SB(1, 1), b3 + hstep, voffB);
            PG8_WAIT_V(6); PG8_BAR; PG8_MMA(1, 1, At, B1); PG8_BAR;
            }
        }
        if constexpr (ALIGN_EPI) { if (wr == 0) PG8_BAR; }
        if constexpr (!Epi::AFTER_DRAIN) { E(acc, cur, wr, wc, fr, fq); S.done(cur); }
        if (!has_next) break;
#pragma unroll
        for (int a = 0; a < 2; ++a)
#pragma unroll
            for (int b = 0; b < 2; ++b)
#pragma unroll
                for (int m = 0; m < 4; ++m)
#pragma unroll
                    for (int n = 0; n < 2; ++n) acc[a][b][m][n] = (f32x4){0.f, 0.f, 0.f, 0.f};
        cur = nxt; cA = nA; cB = nB; ++ui;
        if constexpr (ALIGN_EPI) { if (wr == 1) PG8_BAR; }
    }
    PG8_WAIT_V(0);
    if constexpr (!ALIGN_EPI) { if (wr == 0) PG8_BAR; }
    PG8_BAR;
    if constexpr (Epi::AFTER_DRAIN) { E.fused(acc, cur, wr, wc, fr, fq, lds, wid, lane); S.done(cur); }
#undef PG8_SA
#undef PG8_SB
#undef PG8_STAGE
#undef PG8_LDA
#undef PG8_LDB
#undef PG8_MMA
#undef PG8_WAIT_V
#undef PG8_WAIT_L
#undef PG8_BAR
#undef PG8_SCHED
}
}

typedef unsigned short bf16_t;
typedef float f32x4 __attribute__((ext_vector_type(4)));
typedef unsigned u32x4 __attribute__((ext_vector_type(4)));
typedef unsigned u32x2 __attribute__((ext_vector_type(2)));
constexpr int DM = 1024, NB = 4, TL = 8192, LC = 256;
constexpr int MLAT = NB * TL, MCTX = NB * LC, MALL = MLAT + MCTX;
constexpr int NIN0 = 3328, NIN1 = 5120, NHID = 4096;
constexpr float NORM_EPS = 1e-6f;

__device__ __forceinline__ float bf2f(bf16_t b) { return __uint_as_float(((unsigned)b) << 16); }
__device__ __forceinline__ bf16_t f2bf(float f) { unsigned u = __float_as_uint(f); u += 0x7fffu + ((u >> 16) & 1u); return (bf16_t)(u >> 16); }
__device__ __forceinline__ unsigned pk2(float lo, float hi) { return (unsigned)f2bf(lo) | ((unsigned)f2bf(hi) << 16); }
__device__ __forceinline__ float sigmoidf_(float x) { return 1.f / (1.f + __expf(-x)); }
__device__ __forceinline__ float siluf_(float x) { return x / (1.f + __expf(-x)); }
__device__ __forceinline__ float wave_sum(float v) {
#pragma unroll
    for (int o = 1; o < 64; o <<= 1) v += __shfl_xor(v, o);
    return v;
}

constexpr size_t WS_CTL  = 0;
constexpr size_t WS_MOD  = 65536;
constexpr size_t WS_LB   = WS_MOD + 2 * 5 * 6144 * 4;
constexpr size_t WS_GS   = WS_LB + 4096;
constexpr size_t WS_SHW0 = WS_GS + 4 * 5 * 1024 * 4;
constexpr size_t WS_SHW1 = WS_SHW0 + 5 * 3328 * 4;
constexpr size_t WS_SHW2 = WS_SHW1 + 5 * 4096 * 4;
constexpr size_t WS_SHW3 = WS_SHW2 + 5 * 5120 * 4;
constexpr size_t WS_SSQ  = WS_SHW3 + 5 * 4096 * 4;
constexpr size_t WS_BC   = WS_SSQ + (size_t)MALL * 64;
constexpr size_t WS_LORAW = WS_BC + (size_t)MALL * 32;
constexpr size_t WS_HCTX = WS_LORAW + (size_t)196608 * 2;
constexpr size_t WS_WT   = WS_HCTX + (size_t)MCTX * DM * 4;
constexpr size_t WT_IN1 = 0, WT_OUT1 = WT_IN1 + (size_t)NIN1 * DM * 2, WT_W11 = WT_OUT1 + (size_t)DM * DM * 2, WT_W21 = WT_W11 + (size_t)NHID * DM * 2, WT_L1END = WT_W21 + (size_t)NHID * DM * 2;
constexpr size_t WS_BUF0 = WS_WT + WT_L1END;
constexpr size_t WS_BIG  = WS_BUF0 + (size_t)MALL * DM * 2;
constexpr size_t BIG_HB  = (size_t)MALL * NHID * 2;
constexpr size_t BIG_P0END = (size_t)MALL * NIN0 * 2;
constexpr size_t WS_WTL0 = WS_BIG + (size_t)MALL * NIN1 * 2;
constexpr size_t WT_IN0 = WS_WTL0 - WS_WT, WT_OUT0 = WT_IN0 + (size_t)NIN0 * DM * 2, WT_W10 = WT_OUT0 + (size_t)DM * DM * 2, WT_W20 = WT_W10 + (size_t)NHID * DM * 2, WT_L0END = WT_W20 + (size_t)NHID * DM * 2;
constexpr size_t WS_O1   = WS_WTL0;
constexpr size_t WS_SLOC = WS_O1 + (size_t)MLAT * DM * 2;
constexpr size_t WS_DSEG = WS_SLOC + (size_t)64 * 3 * 128 * 128 * 4;
constexpr size_t WS_END  = WS_DSEG + (size_t)64 * 3 * 128 * 4;
static_assert(WS_WT + WT_L0END <= WS_SLOC, "layout");
static_assert(WS_END <= (size_t)512 * 1024 * 1024, "workspace must fit 512 MiB");

__device__ __forceinline__ void gemv5_item(const float* W, int ldw, int n0, const float* s, float* red, float* out, int ldo, const float* bias) {
    const int tid = threadIdx.x, w = tid >> 6, lane = tid & 63;
    float a0 = 0.f, a1 = 0.f, a2 = 0.f, a3 = 0.f, a4 = 0.f;
    const float* wp = W + (size_t)(w * 128) * ldw + n0 + lane;
#pragma unroll 8
    for (int k = 0; k < 128; ++k) { const float wv = wp[(size_t)k * ldw]; const int kk = w * 128 + k;
        a0 += s[kk] * wv; a1 += s[1024 + kk] * wv; a2 += s[2048 + kk] * wv; a3 += s[3072 + kk] * wv; a4 += s[4096 + kk] * wv; }
    red[(w * 5 + 0) * 64 + lane] = a0; red[(w * 5 + 1) * 64 + lane] = a1; red[(w * 5 + 2) * 64 + lane] = a2; red[(w * 5 + 3) * 64 + lane] = a3; red[(w * 5 + 4) * 64 + lane] = a4;
    __syncthreads();
    if (tid < 320) { const int mb = tid >> 6; float r = bias ? bias[n0 + lane] : 0.f;
#pragma unroll
        for (int ww = 0; ww < 8; ++ww) r += red[(ww * 5 + mb) * 64 + lane];
        out[(size_t)mb * ldo + n0 + lane] = r; }
    __syncthreads();
}

__device__ __forceinline__ void transpose_item(const float* W, int K, int N, bf16_t* WT, float* scr, int item, int lane) {
    const int nblk = N / 32, kb = item / nblk, nb = item % nblk, k0 = 64 * kb, n0 = 32 * nb;
#pragma unroll 8
    for (int i = 0; i < 32; ++i) { const int kk = 2 * i + (lane >> 5); scr[kk * 33 + (lane & 31)] = W[(size_t)(k0 + kk) * N + n0 + (lane & 31)]; }
    __builtin_amdgcn_s_waitcnt(0xc07f); asm volatile("" ::: "memory");
    const int c = lane & 7;
#pragma unroll
    for (int j = 0; j < 4; ++j) { const int n = (lane >> 3) + 8 * j; const float* sp = scr + (8 * c) * 33 + n;
        u32x4 o; o.x = pk2(sp[0 * 33], sp[1 * 33]); o.y = pk2(sp[2 * 33], sp[3 * 33]); o.z = pk2(sp[4 * 33], sp[5 * 33]); o.w = pk2(sp[6 * 33], sp[7 * 33]);
        *(u32x4*)(WT + (size_t)(n0 + n) * K + k0 + 8 * c) = o; }
    __builtin_amdgcn_s_waitcnt(0xc07f); asm volatile("" ::: "memory");
}
namespace pg8 {
__device__ __forceinline__ float row_rstd(const float* ssq, int row) {
    const f32x4* p = (const f32x4*)(ssq + (size_t)row * 16); const f32x4 a = p[0], b = p[1], c = p[2], d = p[3];
    const float s = ((a.x + a.y) + (a.z + a.w)) + ((b.x + b.y) + (b.z + b.w)) + ((c.x + c.y) + (c.z + c.w)) + ((d.x + d.y) + (d.z + d.w));
    return rsqrtf(s * (1.f / 1024.f) + NORM_EPS);
}
template <int ACT> struct EpiAct {
    static constexpr bool PERM = true, AFTER_DRAIN = false;
    bf16_t* O; int ldc; const float* ssq; const float* shw; int ncol; bf16_t* vtl; bf16_t* vtc;
    __device__ __forceinline__ void operator()(const f32x4 (&acc)[2][2][4][2], const Unit& u, int wr, int wc, int fr, int fq) const {
        const int row0 = u.pm * BM + wr * 64 + fr, mb = u.pm < 128 ? (u.pm >> 5) : 4;
        const int col0 = u.pn * BM + wc * 32 + 8 * fq;
        f32x4 bv[2][2];
#pragma unroll
        for (int bj = 0; bj < 2; ++bj)
#pragma unroll
            for (int n = 0; n < 2; ++n) bv[bj][n] = *(const f32x4*)(shw + (size_t)mb * ncol + col0 + bj * HALF + 4 * n);
        const bool do_silu = (ACT == 2) && (u.pn < 4);
#pragma unroll
        for (int ai = 0; ai < 2; ++ai)
#pragma unroll
            for (int m = 0; m < 4; ++m) { const int row = row0 + ai * HALF + m * 16; const float rs = row_rstd(ssq, row);
                bf16_t* rowp = O + (size_t)row * ldc + col0;
#pragma unroll
                for (int bj = 0; bj < 2; ++bj) { f32x4 v0 = acc[ai][bj][m][0] * rs + bv[bj][0], v1 = acc[ai][bj][m][1] * rs + bv[bj][1];
                    if (ACT == 1) {
#pragma unroll
                        for (int j = 0; j < 4; ++j) { const float a = fmaxf(v0[j], 0.f), b = fmaxf(v1[j], 0.f); v0[j] = a * a; v1[j] = b * b; } }
                    if (ACT == 2) { if (do_silu) {
#pragma unroll
                        for (int j = 0; j < 4; ++j) { v0[j] = siluf_(v0[j]); v1[j] = siluf_(v1[j]); } } }
                    u32x4 w; w.x = cvt_pk_bf16(v0[0], v0[1]); w.y = cvt_pk_bf16(v0[2], v0[3]); w.z = cvt_pk_bf16(v1[0], v1[1]); w.w = cvt_pk_bf16(v1[2], v1[3]);
                    *(u32x4*)(rowp + bj * HALF) = w;
                    if (ACT == 3) { if (u.pn >= 11) { const int cv = col0 + bj * HALF - 2816, hh = cv >> 6, d0 = cv & 63;
                        const bool lat = u.pm < 128; const int bb = lat ? (row >> 13) : ((row - MLAT) >> 8), tt = lat ? (row & 8191) : ((row - MLAT) & 255);
                        bf16_t* vp = lat ? vtl + ((size_t)(bb * 8 + hh) * 64 + d0) * TL + tt : vtc + ((size_t)(bb * 8 + hh) * 64 + d0) * LC + tt; const size_t ld = lat ? TL : LC;
#pragma unroll
                        for (int jj = 0; jj < 4; ++jj) { vp[(size_t)(2 * jj) * ld] = (bf16_t)(w[jj] & 0xffffu); vp[(size_t)(2 * jj + 1) * ld] = (bf16_t)(w[jj] >> 16); } } } } }
    }
};
template <bool HB> struct EpiRes {
    static constexpr bool PERM = false, AFTER_DRAIN = false;
    const float* hin_lat; const float* hin_ctx; float* hout_lat; float* hout_ctx; const float* gate; const float* gsn; bf16_t* hb; float* ssq;
    __device__ __forceinline__ void operator()(const f32x4 (&acc)[2][2][4][2], const Unit& u, int wr, int wc, int fr, int fq) const {
        const bool lat = u.pm < 128; const int mb = lat ? (u.pm >> 5) : 4;
        const int row0 = u.pm * BM + wr * 64 + fr, col0 = u.pn * BM + wc * 32 + 4 * fq;
        const float* hin = lat ? hin_lat : hin_ctx - (size_t)MLAT * DM; float* hout = lat ? hout_lat : hout_ctx - (size_t)MLAT * DM;
        f32x4 gv[2][2], gn[2][2];
#pragma unroll
        for (int bj = 0; bj < 2; ++bj)
#pragma unroll
            for (int n = 0; n < 2; ++n) { gv[bj][n] = *(const f32x4*)(gate + (size_t)mb * 6144 + col0 + bj * HALF + n * 16);
                if (HB) gn[bj][n] = *(const f32x4*)(gsn + (size_t)mb * 1024 + col0 + bj * HALF + n * 16); }
#pragma unroll
        for (int ai = 0; ai < 2; ++ai)
#pragma unroll
            for (int m = 0; m < 4; ++m) { const int row = row0 + ai * HALF + m * 16; const size_t off = (size_t)row * DM + col0; float s = 0.f;
#pragma unroll
                for (int bj = 0; bj < 2; ++bj)
#pragma unroll
                    for (int n = 0; n < 2; ++n) { const f32x4 hi = *(const f32x4*)(hin + off + bj * HALF + n * 16); const f32x4 ho = hi + gv[bj][n] * acc[ai][bj][m][n];
                        *(f32x4*)(hout + off + bj * HALF + n * 16) = ho; s += (ho.x * ho.x + ho.y * ho.y) + (ho.z * ho.z + ho.w * ho.w);
                        if (HB) { const f32x4 hn = ho * gn[bj][n]; u32x2 w; w.x = cvt_pk_bf16(hn.x, hn.y); w.y = cvt_pk_bf16(hn.z, hn.w); *(u32x2*)(hb + off + bj * HALF + n * 16) = w; } }
                s += __shfl_xor(s, 16); s += __shfl_xor(s, 32);
                if (fq == 0) ssq[(size_t)row * 16 + u.pn * 4 + wc] = s;
                asm volatile("" ::: "memory"); }
    }
};
}

struct RwkvW { const float *mu_prev, *mu_next, *w0, *w_up, *a0, *a_up, *g_up, *k_k, *k_a, *r_k, *ln_g, *ln_b; };
struct RwkvTmp { bf16_t *r, *k, *v, *kk, *a0, *a1, *g; float *lw0, *lw1, *osum; };
__device__ __forceinline__ void lrow_info(int lr, int b0, int nbh, int& grow, int& t, int& slen) {
    if (lr < nbh * TL) { const int b = b0 + lr / TL; t = lr % TL; grow = b * TL + t; slen = TL; }
    else { const int l2 = lr - nbh * TL; const int b = b0 + l2 / LC; t = l2 % LC; grow = MLAT + b * LC + t; slen = LC; }
}
__device__ __forceinline__ float shifted(const bf16_t* p0, int grow, int t, int slen, int col, float mup, float mun) {
    const float x = bf2f(p0[(size_t)grow * NIN0 + col]);
    const float xp = t > 0 ? bf2f(p0[(size_t)(grow - 1) * NIN0 + col]) : 0.f;
    const float xn = t < slen - 1 ? bf2f(p0[(size_t)(grow + 1) * NIN0 + col]) : 0.f;
    return x + (xp - x) * mup + (xn - x) * mun;
}
struct ScanIn { u32x4 r[2], k[2], kk[2], a[2]; f32x4 lw[4]; float v; };
__device__ __forceinline__ void scan_load(ScanIn& I, const RwkvTmp& T, int dir, size_t lrow, int h, int v, int kq) {
    const size_t o = lrow * 512 + h * 64 + kq * 16;
    const u32x4* pr = (const u32x4*)(T.r + o); const u32x4* pk = (const u32x4*)(T.k + o); const u32x4* pkk = (const u32x4*)(T.kk + o); const u32x4* pa = (const u32x4*)((dir ? T.a1 : T.a0) + o);
    const f32x4* pl = (const f32x4*)((dir ? T.lw1 : T.lw0) + o);
    I.r[0] = pr[0]; I.r[1] = pr[1]; I.k[0] = pk[0]; I.k[1] = pk[1]; I.kk[0] = pkk[0]; I.kk[1] = pkk[1]; I.a[0] = pa[0]; I.a[1] = pa[1];
    I.lw[0] = pl[0]; I.lw[1] = pl[1]; I.lw[2] = pl[2]; I.lw[3] = pl[3];
    I.v = bf2f(T.v[lrow * 512 + h * 64 + v]);
}
__device__ __forceinline__ float bfu(unsigned w, int hi) { return __uint_as_float(hi ? (w & 0xffff0000u) : (w << 16)); }
#define LAS __attribute__((address_space(3)))
#define GAS __attribute__((address_space(1)))
constexpr int NWAVES = 8, NTHREADS = 512;
constexpr int RING_BYTES = 131072, LDS_BYTES = 147456, LDSCTL_OFF = LDS_BYTES - 1024, MISC_OFF = LDSCTL_OFF + 320;
constexpr int CW_BAR = 4096;
constexpr size_t CTL_ZERO_BYTES = 65536;

struct MP { const float* in[30]; float* out; char* ws; int ph_lo, ph_hi; };
#define XB_TMO      128
#define XB_XCNT(j)  (256  + 64 * (j))
#define XB_XSUB(j)  (1280 + 64 * (j))
#define XB_XGEN(j)  (2304 + 64 * (j))
#define XB_TOP      3328
#define XB_TOPGEN   3392
#define XCD_BAR_WORDS 3456
#define XB_SPIN_CAP (1u << 18)

__device__ __forceinline__ unsigned xb_ld(unsigned* p)              { return __hip_atomic_load(p, __ATOMIC_RELAXED, __HIP_MEMORY_SCOPE_AGENT); }
__device__ __forceinline__ unsigned xb_add(unsigned* p, unsigned v) { return __hip_atomic_fetch_add(p, v, __ATOMIC_RELAXED, __HIP_MEMORY_SCOPE_AGENT); }
__device__ __forceinline__ unsigned xb_xcc_id() { return (unsigned)__builtin_amdgcn_s_getreg((3 << 11) | 20) & 0xFu; }
#define XB_SPIN(cond, bar) do { unsigned _sp = 0; while (cond) { __builtin_amdgcn_s_sleep(1); \
    if ((++_sp & 255u) == 0u) { if (xb_ld(&(bar)[XB_TMO])) break; if (_sp > XB_SPIN_CAP) { atomicAdd(&(bar)[XB_TMO], 1u); break; } } } } while (0)

struct XcdBarrier {
    unsigned* bar; unsigned x;
    volatile LAS unsigned* st;
};

__device__ __forceinline__ XcdBarrier xcd_barrier_post(unsigned* bar, volatile LAS unsigned* st) {
    XcdBarrier b; b.bar = bar; b.x = xb_xcc_id(); b.st = st;
    if (threadIdx.x == 0) (void)xb_add(&bar[XB_XCNT(b.x)], 1u);
    return b;
}
__device__ __forceinline__ void xcd_barrier_complete(unsigned* bar, unsigned x, unsigned& nloc, unsigned& nx) {
    const unsigned G = gridDim.x * gridDim.y * gridDim.z;
    unsigned sum, cnt, mine, sp = 0u;
    for (;;) {
        sum = 0u; cnt = 0u; mine = 0u;
#pragma unroll
        for (unsigned j = 0; j < 16; ++j) { const unsigned c = xb_ld(&bar[XB_XCNT(j)]); sum += c; cnt += (c > 0u) ? 1u : 0u; mine = (j == x) ? c : mine; }
        if (sum == G) break;
        __builtin_amdgcn_s_sleep(1);
        if ((++sp & 255u) == 0u) { if (xb_ld(&bar[XB_TMO])) break; if (sp > XB_SPIN_CAP) { atomicAdd(&bar[XB_TMO], 1u); break; } }
    }
    nloc = mine > 0u ? mine : 1u; nx = cnt > 0u ? cnt : 1u;
}

__device__ __forceinline__ void xcd_barrier(const XcdBarrier& b) {
    asm volatile("s_waitcnt vmcnt(0)" ::: "memory");
    __syncthreads();
    if (threadIdx.x == 0) {
        unsigned* bar = b.bar;
        __builtin_amdgcn_s_waitcnt(0);
        unsigned nloc = b.st[0], nx = b.st[1];
        if (nloc == 0u) { xcd_barrier_complete(bar, b.x, nloc, nx); b.st[0] = nloc; b.st[1] = nx; }
        const unsigned old = xb_add(&bar[XB_XSUB(b.x)], 1u);
        const unsigned gen = old / nloc;
        if (old + 1u == (gen + 1u) * nloc) {
            __builtin_amdgcn_fence(__ATOMIC_RELEASE, "agent");
            asm volatile("s_waitcnt vmcnt(0)" ::: "memory");
            const unsigned og = xb_add(&bar[XB_TOP], 1u);
            const unsigned tg = og / nx;
            if (og + 1u == (tg + 1u) * nx) xb_add(&bar[XB_TOPGEN], 1u);
            else XB_SPIN(xb_ld(&bar[XB_TOPGEN]) == tg, bar);
            __builtin_amdgcn_fence(__ATOMIC_ACQUIRE, "agent");
            xb_add(&bar[XB_XGEN(b.x)], 1u);
            asm volatile("s_waitcnt vmcnt(0)" ::: "memory");
        } else {
            XB_SPIN(xb_ld(&bar[XB_XGEN(b.x)]) == gen, bar);
            __builtin_amdgcn_fence(__ATOMIC_ACQUIRE, "agent");
            asm volatile("s_waitcnt vmcnt(0)" ::: "memory");
        }
    }
    __syncthreads();
}

typedef short bf16x8_t __attribute__((ext_vector_type(8)));
typedef short bf16x4_t __attribute__((ext_vector_type(4)));
constexpr int HG_NSEG = 4, HG_SEGCH = 33;
constexpr int HG_QH = 0, HG_KH = 17408, HG_KP = 34816, HG_VT = 53248, HG_ATT = 71680, HG_TOT = 80896, HG_EBL = 82944;
constexpr int HG_LDA = 136, HG_LDB = 72;

__device__ __forceinline__ bf16x8_t pack8(const f32x4& a, const f32x4& b) {
    u32x4 w; w.x = pg8::cvt_pk_bf16(a.x, a.y); w.y = pg8::cvt_pk_bf16(a.z, a.w); w.z = pg8::cvt_pk_bf16(b.x, b.y); w.w = pg8::cvt_pk_bf16(b.z, b.w);
    return __builtin_bit_cast(bf16x8_t, w);
}
__device__ __forceinline__ bf16x8_t join8(const bf16x4_t a, const bf16x4_t b) { bf16x8_t r; r[0] = a[0]; r[1] = a[1]; r[2] = a[2]; r[3] = a[3]; r[4] = b[0]; r[5] = b[1]; r[6] = b[2]; r[7] = b[3]; return r; }

template <bool OUT>
__device__ __forceinline__ void hgrn_chunk(const bf16_t* __restrict__ p1, long row0, int rstep, int d, int h, float lbk, f32x4 (&S)[8], float& bsum, bf16_t* Obuf, LAS unsigned char* lds) {
    const int tid = threadIdx.x, kc = tid & 127, tg = tid >> 7, w = tid >> 6, lane = tid & 63, fr = lane & 15, fq = lane >> 4;
    LAS bf16_t* QH = (LAS bf16_t*)(lds + HG_QH); LAS bf16_t* KH = (LAS bf16_t*)(lds + HG_KH); LAS bf16_t* KP = (LAS bf16_t*)(lds + HG_KP); LAS bf16_t* VT = (LAS bf16_t*)(lds + HG_VT);
    LAS bf16_t* ATT = (LAS bf16_t*)(lds + HG_ATT); LAS float* TOT = (LAS float*)(lds + HG_TOT); LAS float* EBL = (LAS float*)(lds + HG_EBL);
    float fv[16], qv[16], iv[16];
    { const bf16_t* rp = p1 + (size_t)(row0 + (long)rstep * (16 * tg)) * NIN1 + h * 128 + kc; const long rs = (long)rstep * NIN1; const int fo = d ? 2048 : 1024;
#pragma unroll
      for (int p = 0; p < 16; ++p) { fv[p] = bf2f(rp[fo]); if (OUT) qv[p] = bf2f(rp[0]); iv[p] = bf2f(rp[3072]); rp += rs; } }
    float kvv[16], bl[16]; float run = 0.f;
#pragma unroll
    for (int p = 0; p < 16; ++p) { const float e = __expf(-fv[p]), sg = 1.f / (1.f + e); const float fg = lbk + (1.f - lbk) * sg; run += __logf(fg); bl[p] = run; kvv[p] = (1.f - lbk) * e * sg; }
    TOT[tg * 128 + kc] = run;
    __syncthreads();
    float prefix = 0.f, blast = 0.f;
#pragma unroll
    for (int g = 0; g < 4; ++g) { const float t = TOT[g * 128 + kc]; blast += t; if (g < tg) prefix += t; }
    {   unsigned kpw[8], vtw[8];
#pragma unroll
        for (int p = 0; p < 16; p += 2) { float kpv[2];
#pragma unroll
            for (int e2 = 0; e2 < 2; ++e2) { const int pp = p + e2; const float b = prefix + bl[pp]; const float eb = __expf(b), ieb = 1.f / eb;
                if (OUT) { QH[(16 * tg + pp) * HG_LDA + kc] = f2bf(qv[pp] * eb); KH[(16 * tg + pp) * HG_LDA + kc] = f2bf(kvv[pp] * ieb); }
                kpv[e2] = kvv[pp] * __expf(blast - b); }
            kpw[p >> 1] = pg8::cvt_pk_bf16(kpv[0], kpv[1]); vtw[p >> 1] = pg8::cvt_pk_bf16(iv[p], iv[p + 1]); }
        LAS u32x4* kp4 = (LAS u32x4*)(KP + kc * HG_LDB + 16 * tg); LAS u32x4* vt4 = (LAS u32x4*)(VT + kc * HG_LDB + 16 * tg);
        kp4[0] = (u32x4){kpw[0], kpw[1], kpw[2], kpw[3]}; kp4[1] = (u32x4){kpw[4], kpw[5], kpw[6], kpw[7]};
        vt4[0] = (u32x4){vtw[0], vtw[1], vtw[2], vtw[3]}; vt4[1] = (u32x4){vtw[4], vtw[5], vtw[6], vtw[7]}; }
    if (tg == 0) { EBL[kc] = __expf(blast); bsum += blast; }
    __syncthreads();
    if (OUT) {
#pragma unroll
        for (int q = 0; q < 2; ++q) { const int id = w + 8 * q, st = id >> 2, tt = id & 3;
            f32x4 a = (f32x4){0.f, 0.f, 0.f, 0.f};
            if (st <= tt) {
#pragma unroll
                for (int ks = 0; ks < 4; ++ks) { const bf16x8_t A = *(const LAS bf16x8_t*)(KH + (16 * st + fr) * HG_LDA + 32 * ks + 8 * fq); const bf16x8_t B = *(const LAS bf16x8_t*)(QH + (16 * tt + fr) * HG_LDA + 32 * ks + 8 * fq);
                    a = __builtin_amdgcn_mfma_f32_16x16x32_bf16(A, B, a, 0, 0, 0); }
                if (st == tt) {
#pragma unroll
                    for (int r = 0; r < 4; ++r) if (4 * fq + r > fr) a[r] = 0.f; } }
            u32x2 wv; wv.x = pg8::cvt_pk_bf16(a.x, a.y); wv.y = pg8::cvt_pk_bf16(a.z, a.w);
            *(LAS u32x2*)(ATT + (16 * tt + fr) * HG_LDB + 16 * st + 4 * fq) = wv; }
        __syncthreads();
        f32x4 o[4];
#pragma unroll
        for (int tt = 0; tt < 4; ++tt) o[tt] = (f32x4){0.f, 0.f, 0.f, 0.f};
#pragma unroll
        for (int ks = 0; ks < 4; ++ks) { const bf16x8_t Bs = pack8(S[2 * ks], S[2 * ks + 1]);
#pragma unroll
            for (int tt = 0; tt < 4; ++tt) { const LAS bf16_t* qp = QH + (16 * tt + fr) * HG_LDA + 32 * ks + 4 * fq;
                const bf16x8_t A = join8(*(const LAS bf16x4_t*)qp, *(const LAS bf16x4_t*)(qp + 16));
                o[tt] = __builtin_amdgcn_mfma_f32_16x16x32_bf16(A, Bs, o[tt], 0, 0, 0); } }
#pragma unroll
        for (int sp = 0; sp < 2; ++sp) { const bf16x8_t Bv = *(const LAS bf16x8_t*)(VT + (16 * w + fr) * HG_LDB + 32 * sp + 8 * fq);
#pragma unroll
            for (int tt = 0; tt < 4; ++tt) { if (sp == 1 && tt < 2) continue;
                const bf16x8_t A = *(const LAS bf16x8_t*)(ATT + (16 * tt + fr) * HG_LDB + 32 * sp + 8 * fq);
                o[tt] = __builtin_amdgcn_mfma_f32_16x16x32_bf16(A, Bv, o[tt], 0, 0, 0); } }
#pragma unroll
        for (int tt = 0; tt < 4; ++tt)
#pragma unroll
            for (int r = 0; r < 4; ++r) { const int t = 16 * tt + 4 * fq + r; Obuf[(size_t)(row0 + (long)rstep * t) * DM + h * 128 + 16 * w + fr] = f2bf(o[tt][r]); }
    }
#pragma unroll
    for (int kt = 0; kt < 8; ++kt) { const f32x4 e4 = *(const LAS f32x4*)(EBL + 16 * kt + 4 * fq); S[kt] = S[kt] * e4; }
#pragma unroll
    for (int sp = 0; sp < 2; ++sp) { const bf16x8_t Bv = *(const LAS bf16x8_t*)(VT + (16 * w + fr) * HG_LDB + 32 * sp + 8 * fq);
#pragma unroll
        for (int kt = 0; kt < 8; ++kt) { const bf16x8_t A = *(const LAS bf16x8_t*)(KP + (16 * kt + fr) * HG_LDB + 32 * sp + 8 * fq);
            S[kt] = __builtin_amdgcn_mfma_f32_16x16x32_bf16(A, Bv, S[kt], 0, 0, 0); } }
    __syncthreads();
}

__device__ __forceinline__ void hgrn_chunk_rows(int d, int b, int cc, long& row0, int& rstep) {
    if (cc < 4) { const int t0 = d ? LC - 1 - 64 * cc : 64 * cc; row0 = (long)MLAT + b * LC + t0; }
    else { const int c2 = cc - 4; const int t0 = d ? TL - 1 - 64 * c2 : 64 * c2; row0 = (long)b * TL + t0; }
    rstep = d ? -1 : 1;
}

template <bool PASSC>
__device__ __forceinline__ void ph_hgrn(const MP& p, int bid, int nblk, LAS unsigned char* lds) {
    const bf16_t* p1 = (const bf16_t*)(p.ws + WS_BIG); const float* lbv = (const float*)(p.ws + WS_LB);
    float* SLOC = (float*)(p.ws + WS_SLOC); float* DSEG = (float*)(p.ws + WS_DSEG);
    const int tid = threadIdx.x, kc = tid & 127, tg = tid >> 7, w = tid >> 6, lane = tid & 63, fr = lane & 15, fq = lane >> 4;
    const int nunits = PASSC ? 64 * 4 : 64 * 3;
    for (int u = bid; u < nunits; u += nblk) {
        const int chain = PASSC ? (u >> 2) : (u / 3), seg = PASSC ? (u & 3) : (u % 3);
        const int d = chain >> 5, b = (chain >> 3) & 3, h = chain & 7;
        const float lbk = lbv[h * 128 + kc];
        f32x4 S[8];
#pragma unroll
        for (int kt = 0; kt < 8; ++kt) S[kt] = (f32x4){0.f, 0.f, 0.f, 0.f};
        if (PASSC && seg > 0) {
            for (int jj = 0; jj < seg; ++jj) { const f32x4* sl = (const f32x4*)(SLOC + (size_t)(chain * 3 + jj) * 128 * 128) + (w * 8) * 64 + lane; const float* ds = DSEG + (size_t)(chain * 3 + jj) * 128 + 4 * fq;
#pragma unroll
                for (int kt = 0; kt < 8; ++kt) { f32x4 dd = *(const f32x4*)(ds + 16 * kt); if (jj == 0) dd = (f32x4){0.f, 0.f, 0.f, 0.f}; S[kt] = dd * S[kt] + sl[kt * 64]; } } }
        float bsum = 0.f;
        bf16_t* Obuf = (bf16_t*)(p.ws + (d ? WS_O1 : WS_BUF0));
        for (int ci = 0; ci < HG_SEGCH; ++ci) { const int cc = seg * HG_SEGCH + ci; long row0; int rstep; hgrn_chunk_rows(d, b, cc, row0, rstep);
            if (PASSC && cc >= 4) hgrn_chunk<true>(p1, row0, rstep, d, h, lbk, S, bsum, Obuf, lds);
            else hgrn_chunk<false>(p1, row0, rstep, d, h, lbk, S, bsum, Obuf, lds); }
        if (!PASSC) { f32x4* sl = (f32x4*)(SLOC + (size_t)(chain * 3 + seg) * 128 * 128) + (w * 8) * 64 + lane;
#pragma unroll
            for (int kt = 0; kt < 8; ++kt) sl[kt * 64] = S[kt];
            if (tg == 0) DSEG[(size_t)(chain * 3 + seg) * 128 + kc] = __expf(bsum); }
    }
}
__device__ __forceinline__ void ph_hgrn_out2(const MP& p, int bid, int nblk) {
    bf16_t* o0 = (bf16_t*)(p.ws + WS_BUF0); const bf16_t* o1 = (const bf16_t*)(p.ws + WS_O1); const bf16_t* p1 = (const bf16_t*)(p.ws + WS_BIG); const float* g = p.in[28];
    const int w = threadIdx.x >> 6, lane = threadIdx.x & 63;
    for (int row = bid * 8 + w; row < MLAT; row += nblk * 8) {
        u32x4* a4 = (u32x4*)(o0 + (size_t)row * DM + lane * 16); const u32x4* b4 = (const u32x4*)(o1 + (size_t)row * DM + lane * 16); const u32x4* g4 = (const u32x4*)(p1 + (size_t)row * NIN1 + 4096 + lane * 16);
        float o[16], gt[16]; float s = 0.f;
#pragma unroll
        for (int q = 0; q < 2; ++q) { const u32x4 a = a4[q], bb = b4[q], gg = g4[q];
#pragma unroll
            for (int j = 0; j < 4; ++j) { o[q * 8 + 2 * j] = bfu(a[j], 0) + bfu(bb[j], 0); o[q * 8 + 2 * j + 1] = bfu(a[j], 1) + bfu(bb[j], 1); gt[q * 8 + 2 * j] = bfu(gg[j], 0); gt[q * 8 + 2 * j + 1] = bfu(gg[j], 1); } }
#pragma unroll
        for (int i = 0; i < 16; ++i) s += o[i] * o[i];
        s = wave_sum(s); const float rs = rsqrtf(s * (1.f / 1024.f) + NORM_EPS);
        const f32x4* gn = (const f32x4*)(g + lane * 16);
#pragma unroll
        for (int q = 0; q < 2; ++q) { u32x4 st;
#pragma unroll
            for (int j = 0; j < 4; ++j) { const int i0 = q * 8 + 2 * j; const float y0 = o[i0] * rs * gn[i0 >> 2][i0 & 3] * siluf_(gt[i0]), y1 = o[i0 + 1] * rs * gn[(i0 + 1) >> 2][(i0 + 1) & 3] * siluf_(gt[i0 + 1]); st[j] = pk2(y0, y1); }
            a4[q] = st; }
    }
}

typedef short bf16x4s __attribute__((ext_vector_type(4)));
constexpr int RW_NCH = 132;
constexpr int RW_P = 72;
__device__ __forceinline__ constexpr int R_AT(int d) { return d * 36864; }
__device__ __forceinline__ constexpr int R_RT(int d) { return d * 36864 + 9216; }
__device__ __forceinline__ constexpr int R_BT(int d) { return d * 36864 + 18432; }
__device__ __forceinline__ constexpr int R_KT(int d) { return d * 36864 + 27648; }
__device__ __forceinline__ constexpr int R_AB(int d) { return 73728 + d * 16384; }
__device__ __forceinline__ constexpr int R_DG(int d) { return 73728 + d * 16384 + 9216; }
__device__ __forceinline__ constexpr int R_TJ(int d) { return 73728 + d * 16384 + 13312; }
constexpr int R_SCR = 106496;
__device__ __forceinline__ constexpr int R_VT(int d) { return 112640 + d * 9216; }
constexpr int R_GG = 131072;
constexpr int R_KN = 139520;
__device__ __forceinline__ constexpr int R_WC(int d) { return 139776 + d * 256; }
constexpr int R_BCP = 140288;
constexpr int R_END = 142336;
constexpr int R_TL = 73728, R_AL = 82944, R_GL = 92160;
constexpr int R_OX = 73728;
constexpr int GGP = 66, GLP = 136;

struct RwkvG {
    unsigned char* MA; unsigned char* ZT0; unsigned char* ZT1; unsigned char* SC;
};
__device__ __forceinline__ RwkvG mk_rwkvg(const MP& p) {
    RwkvG g; unsigned char* t0 = (unsigned char*)p.out; unsigned char* t1 = (unsigned char*)(p.ws + WS_BIG + BIG_P0END);
    const size_t half = (size_t)32 * RW_NCH * 8192;
    g.MA = t0; g.ZT0 = t0 + 2 * half; g.SC = t1; g.ZT1 = t1 + 2 * half; return g; }

__device__ __forceinline__ float lds_f(const LAS unsigned char* lds, int off) { return *(const LAS float*)(lds + off); }
__device__ __forceinline__ f32x4 unpack4(u32x2 w) { f32x4 r; r.x = bfu(w.x, 0); r.y = bfu(w.x, 1); r.z = bfu(w.y, 0); r.w = bfu(w.y, 1); return r; }
__device__ __forceinline__ u32x2 pack4(const f32x4& a) { u32x2 w; w.x = pg8::cvt_pk_bf16(a.x, a.y); w.y = pg8::cvt_pk_bf16(a.z, a.w); return w; }
#define MFMA32(A, B, C) __builtin_amdgcn_mfma_f32_16x16x32_bf16((A), (B), (C), 0, 0, 0)
#define MFMA16(A, B, C) __builtin_amdgcn_mfma_f32_16x16x16bf16_1k((A), (B), (C), 0, 0, 0)
#define LDS_B128(off) (*(const LAS bf16x8_t*)(lds + (off)))
#define LDS_B64(off)  (*(const LAS bf16x4s*)(lds + (off)))
#define CFENCE() asm volatile("" ::: "memory")

__device__ __forceinline__ void ph_lora_w(const MP& p, int bid, int nblk) {
    const float* w_up = p.in[15]; const float* a_up = p.in[17]; const float* g_up = p.in[18];
    bf16_t* WUT = (bf16_t*)(p.ws + WS_LORAW); bf16_t* AUT = WUT + 65536; bf16_t* GUT = AUT + 65536;
    for (int i = bid * 512 + threadIdx.x; i < 196608; i += nblk * 512) {
        if (i < 65536) { const int d = i >> 15, c = (i >> 6) & 511, j = i & 63; WUT[i] = f2bf(w_up[(size_t)(d * 64 + j) * 512 + c]); }
        else if (i < 131072) { const int q = i - 65536, d = q >> 15, c = (q >> 6) & 511, j = q & 63; AUT[q] = f2bf(a_up[(size_t)(d * 64 + j) * 512 + c]); }
        else { const int q = i - 131072, c = q >> 7, j = q & 127; GUT[q] = f2bf(g_up[(size_t)j * 512 + c]); } }
}

template <int MODE>
__device__ __forceinline__ void rwkv_unit(const MP& p, int u, LAS unsigned char* lds) {
    const bf16_t* __restrict__ p0 = (const bf16_t*)(p.ws + WS_BIG);
    const float* mu_prev = p.in[12]; const float* mu_next = p.in[13]; const float* w0 = p.in[14]; const float* a0 = p.in[16];
    const float* k_k = p.in[19]; const float* k_a = p.in[20]; const float* r_k = p.in[21]; const float* ln_g = p.in[22]; const float* ln_b = p.in[23];
    const bf16_t* WUT = (const bf16_t*)(p.ws + WS_LORAW); const bf16_t* AUT = WUT + 65536; const bf16_t* GUT = AUT + 65536;
    const RwkvG RG = mk_rwkvg(p);
    int tid_ = threadIdx.x; asm volatile("" : "+v"(tid_));
    const int tid = tid_, w = __builtin_amdgcn_readfirstlane(tid >> 6), lane = tid & 63, fr = lane & 15, fq = lane >> 4;
    const int h = u & 7, tc = (u >> 3) % RW_NCH, b = u / (8 * RW_NCH);
    const bool isctx = tc < 4; const int tcl = isctx ? tc : tc - 4, slen = isctx ? LC : TL;
    const long base_row = isctx ? (long)MLAT + b * LC + 64 * tcl : (long)b * TL + 64 * tcl;
    const int tseq0 = 64 * tcl;

    {   const int col = tid & 255, th = tid >> 8;
        if (MODE == 1 || col < 128) {
            const int pc = 1536 + col; const float mup = mu_prev[pc], mun = mu_next[pc];
            const bf16_t* rp = p0 + (size_t)(base_row + 32 * th) * NIN0 + pc;
            float xp = (tseq0 + 32 * th > 0) ? bf2f(rp[-(long)NIN0]) : 0.f, x = bf2f(rp[0]);
#pragma unroll 4
            for (int i = 0; i < 32; ++i) { const int tok = 32 * th + i; const float xn = (tseq0 + tok < slen - 1) ? bf2f(rp[NIN0]) : 0.f;
                const float s = x + (xp - x) * mup + (xn - x) * mun;
                if (col < 64) *(LAS bf16_t*)(lds + R_TL + (tok * RW_P + col) * 2) = f2bf(tanhf(s));
                else if (col < 128) *(LAS bf16_t*)(lds + R_AL + (tok * RW_P + col - 64) * 2) = f2bf(s);
                else *(LAS bf16_t*)(lds + R_GL + (tok * GLP + col - 128) * 2) = f2bf(sigmoidf_(s));
                xp = x; x = xn; rp += NIN0; } }
        {   const int tok = tid >> 3, c0 = (tid & 7) * 8; const int pc = 512 + h * 64 + c0;
            const bf16_t* rp = p0 + (size_t)(base_row + tok) * NIN0 + pc;
            const bool hp = tseq0 + tok > 0, hn = tseq0 + tok < slen - 1;
            const u32x4 x4 = *(const u32x4*)rp; u32x4 p4 = (u32x4){0u, 0u, 0u, 0u}, n4 = (u32x4){0u, 0u, 0u, 0u};
            if (hp) p4 = *(const u32x4*)(rp - (long)NIN0); if (hn) n4 = *(const u32x4*)(rp + NIN0);
            float s = 0.f;
#pragma unroll
            for (int j = 0; j < 8; ++j) { const float x = bfu(x4[j >> 1], j & 1), xp = bfu(p4[j >> 1], j & 1), xn = bfu(n4[j >> 1], j & 1);
                const float kv = (x + (xp - x) * mu_prev[pc + j] + (xn - x) * mu_next[pc + j]) * k_k[h * 64 + c0 + j]; s += kv * kv; }
            s += __shfl_xor(s, 1); s += __shfl_xor(s, 2); s += __shfl_xor(s, 4);
            if ((tid & 7) == 0) *(LAS float*)(lds + R_KN + tok * 4) = 1.f / fmaxf(sqrtf(s), 1e-12f); }
    }
    __syncthreads();

    const int d = w >> 2, ct = w & 3;
    const int hc = h * 64 + 16 * ct + fr;
    u32x2 bhp[4], khp[4];
    {
        f32x4 wl[4], al[4];
        {   bf16x8_t Bw[2], Ba[2];
#pragma unroll
            for (int ks = 0; ks < 2; ++ks) { Bw[ks] = *(const bf16x8_t*)(WUT + (size_t)(d * 512 + hc) * 64 + 32 * ks + 8 * fq); Ba[ks] = *(const bf16x8_t*)(AUT + (size_t)(d * 512 + hc) * 64 + 32 * ks + 8 * fq); }
            const float w0v = w0[d * 512 + hc], a0v = a0[d * 512 + hc];
#pragma unroll
            for (int tt = 0; tt < 4; ++tt) { f32x4 aw = (f32x4){w0v, w0v, w0v, w0v}, aa = (f32x4){a0v, a0v, a0v, a0v};
#pragma unroll
                for (int ks = 0; ks < 2; ++ks) { aw = MFMA32(LDS_B128(R_TL + ((16 * tt + fr) * RW_P + 32 * ks + 8 * fq) * 2), Bw[ks], aw); aa = MFMA32(LDS_B128(R_AL + ((16 * tt + fr) * RW_P + 32 * ks + 8 * fq) * 2), Ba[ks], aa); }
                wl[tt] = aw; al[tt] = aa; } }
        if (MODE == 1) {
#pragma unroll
            for (int q = 0; q < 2; ++q) { const int id = 2 * w + q, tt = id >> 2, cg = id & 3; f32x4 ag = (f32x4){0.f, 0.f, 0.f, 0.f};
#pragma unroll
                for (int ks = 0; ks < 4; ++ks) ag = MFMA32(LDS_B128(R_GL + ((16 * tt + fr) * GLP + 32 * ks + 8 * fq) * 2), *(const bf16x8_t*)(GUT + (size_t)(h * 64 + 16 * cg + fr) * 128 + 32 * ks + 8 * fq), ag);
#pragma unroll
                for (int r = 0; r < 4; ++r) *(LAS bf16_t*)(lds + R_GG + ((16 * tt + 4 * fq + r) * GGP + 16 * cg + fr) * 2) = f2bf(ag[r]); } }
        f32x4 lw[4]; float base[4]; float cumC;
        {   float pre[4], tot[4];
#pragma unroll
            for (int tt = 0; tt < 4; ++tt) {
#pragma unroll
                for (int r = 0; r < 4; ++r) lw[tt][r] = -0.60653066f / (1.f + __expf(-wl[tt][r]));
                const float s4 = (lw[tt][0] + lw[tt][1]) + (lw[tt][2] + lw[tt][3]);
                const float u1 = __shfl(s4, (lane + 16) & 63), u2 = __shfl(s4, (lane + 32) & 63), u3 = __shfl(s4, (lane + 48) & 63);
                tot[tt] = (s4 + u1) + (u2 + u3);
                float pr = 0.f;
                if (d == 0) { if (fq >= 1) pr += u3; if (fq >= 2) pr += u2; if (fq >= 3) pr += u1; }
                else        { if (fq <= 2) pr += u1; if (fq <= 1) pr += u2; if (fq <= 0) pr += u3; }
                pre[tt] = pr; }
            cumC = (tot[0] + tot[1]) + (tot[2] + tot[3]);
            base[0] = pre[0] + (d ? (tot[1] + tot[2] + tot[3]) : 0.f); base[1] = pre[1] + (d ? (tot[2] + tot[3]) : tot[0]);
            base[2] = pre[2] + (d ? tot[3] : (tot[0] + tot[1])); base[3] = pre[3] + (d ? 0.f : (tot[0] + tot[1] + tot[2])); }
        const float mpr = mu_prev[hc], mnr = mu_next[hc], mpk = mu_prev[512 + hc], mnk = mu_next[512 + hc], mpv = mu_prev[1024 + hc], mnv = mu_next[1024 + hc];
        const float kkc = k_k[hc], kac = k_a[hc], rkc = r_k[hc];
#pragma unroll
        for (int tt = 0; tt < 4; ++tt) { const int tok0 = 16 * tt + 4 * fq;
            const bf16_t* rp = p0 + (size_t)(base_row + tok0) * NIN0 + hc;
            float xr[6], xk[6], xv[6];
#pragma unroll
            for (int i = 0; i < 6; ++i) { const int ts = tseq0 + tok0 - 1 + i; const bool ok = ts >= 0 && ts < slen; const bf16_t* q = rp + (long)(i - 1) * NIN0;
                xr[i] = ok ? bf2f(q[0]) : 0.f; xk[i] = ok ? bf2f(q[512]) : 0.f; xv[i] = ok ? bf2f(q[1024]) : 0.f; }
            f32x4 cum;
            { const float a0_ = lw[tt][0], a1_ = lw[tt][1], a2_ = lw[tt][2], a3_ = lw[tt][3];
              if (d == 0) { cum[0] = base[tt] + a0_; cum[1] = cum[0] + a1_; cum[2] = cum[1] + a2_; cum[3] = cum[2] + a3_; }
              else        { cum[3] = base[tt] + a3_; cum[2] = cum[3] + a2_; cum[1] = cum[2] + a1_; cum[0] = cum[1] + a0_; } }
            f32x4 vv, bh4, kh4;
#pragma unroll
            for (int r = 0; r < 4; ++r) { const float rs = xr[r + 1] + (xr[r] - xr[r + 1]) * mpr + (xr[r + 2] - xr[r + 1]) * mnr;
                const float ks_ = xk[r + 1] + (xk[r] - xk[r + 1]) * mpk + (xk[r + 2] - xk[r + 1]) * mnk;
                vv[r] = xv[r + 1] + (xv[r] - xv[r + 1]) * mpv + (xv[r + 2] - xv[r + 1]) * mnv;
                const int tok = tok0 + r, pos = d ? 63 - tok : tok;
                const float kk = ks_ * kkc * lds_f(lds, R_KN + tok * 4);
                const float a = sigmoidf_(al[tt][r]);
                const float kdv = ks_ * (1.f + (a - 1.f) * kac), bbv = kk * a;
                const float c = cum[r], ec = __expf(c), en = 1.f / ec, ep = __expf(c - lw[tt][r]), eh = __expf(cumC - c);
                const int o = (pos * RW_P + 16 * ct + fr) * 2;
                *(LAS bf16_t*)(lds + R_AT(0) + d * 36864 + o) = f2bf(-kk * ep);
                *(LAS bf16_t*)(lds + R_BT(0) + d * 36864 + o) = f2bf(bbv * en);
                *(LAS bf16_t*)(lds + R_KT(0) + d * 36864 + o) = f2bf(kdv * en);
                if (MODE == 1) *(LAS bf16_t*)(lds + R_RT(0) + d * 36864 + o) = f2bf(rs * ec);
                bh4[r] = bbv * eh; kh4[r] = kdv * eh;
                if (MODE == 1) { float s = rs * rkc * kdv; s += __shfl_xor(s, 1); s += __shfl_xor(s, 2); s += __shfl_xor(s, 4); s += __shfl_xor(s, 8);
                    if (fr == 0) *(LAS float*)(lds + R_BCP + ((d * 4 + ct) * 64 + tok) * 4) = s; } }
            { f32x4 vo = vv; if (d) vo = (f32x4){vv[3], vv[2], vv[1], vv[0]}; const int pos0 = d ? 63 - (tok0 + 3) : tok0;
              *(LAS u32x2*)(lds + R_VT(0) + d * 9216 + ((16 * ct + fr) * RW_P + pos0) * 2) = pack4(vo); }
            if (MODE == 0) { if (d) { bh4 = (f32x4){bh4[3], bh4[2], bh4[1], bh4[0]}; kh4 = (f32x4){kh4[3], kh4[2], kh4[1], kh4[0]}; } bhp[tt] = pack4(bh4); khp[tt] = pack4(kh4); }
            __builtin_amdgcn_sched_barrier(0);
        }
        if (MODE == 0 && fq == 0) *(LAS float*)(lds + R_WC(0) + d * 256 + (16 * ct + fr) * 4) = __expf(cumC);
    }
    __syncthreads();

    f32x4 yak[2][4];
    f32x4 akr[4]; u32x2 abr[4];
    {
        const int I = w & 3;
#pragma unroll
        for (int dd = 0; dd < 2; ++dd) {
            const int rowbase = (w < 4 ? R_BT(0) : R_KT(0)) + dd * 36864;
            bf16x8_t A0 = LDS_B128(rowbase + ((16 * I + fr) * RW_P + 8 * fq) * 2), A1 = LDS_B128(rowbase + ((16 * I + fr) * RW_P + 32 + 8 * fq) * 2);
#pragma unroll
            for (int J = 0; J < 4; ++J) { f32x4 acc = (f32x4){0.f, 0.f, 0.f, 0.f};
                if (J >= I) { acc = MFMA32(A0, LDS_B128(R_AT(0) + dd * 36864 + ((16 * J + fr) * RW_P + 8 * fq) * 2), acc); acc = MFMA32(A1, LDS_B128(R_AT(0) + dd * 36864 + ((16 * J + fr) * RW_P + 32 + 8 * fq) * 2), acc); }
                if (J == I) {
#pragma unroll
                    for (int r = 0; r < 4; ++r) if (!(4 * fq + r < fr)) acc[r] = 0.f; }
                if (w < 4) {
                    if (J == I) {
#pragma unroll
                        for (int r = 0; r < 4; ++r) *(LAS float*)(lds + R_DG(0) + dd * 16384 + ((J * 16 + 4 * fq + r) * 16 + fr) * 4) = acc[r];
                        acc = (f32x4){0.f, 0.f, 0.f, 0.f}; }
                    *(LAS u32x2*)(lds + R_AB(0) + dd * 16384 + ((16 * J + fr) * RW_P + 16 * I + 4 * fq) * 2) = pack4(acc);
                } else yak[dd][J] = acc; } }
        if (MODE == 1) {
            const int J = ct;
            const bf16x8_t B0 = LDS_B128(R_RT(0) + d * 36864 + ((16 * J + fr) * RW_P + 8 * fq) * 2), B1 = LDS_B128(R_RT(0) + d * 36864 + ((16 * J + fr) * RW_P + 32 + 8 * fq) * 2);
#pragma unroll
            for (int I2 = 0; I2 < 4; ++I2) { f32x4 a1 = (f32x4){0.f, 0.f, 0.f, 0.f}, a2 = (f32x4){0.f, 0.f, 0.f, 0.f};
                if (I2 <= J) {
                    a1 = MFMA32(LDS_B128(R_BT(0) + d * 36864 + ((16 * I2 + fr) * RW_P + 8 * fq) * 2), B0, a1); a1 = MFMA32(LDS_B128(R_BT(0) + d * 36864 + ((16 * I2 + fr) * RW_P + 32 + 8 * fq) * 2), B1, a1);
                    a2 = MFMA32(LDS_B128(R_KT(0) + d * 36864 + ((16 * I2 + fr) * RW_P + 8 * fq) * 2), B0, a2); a2 = MFMA32(LDS_B128(R_KT(0) + d * 36864 + ((16 * I2 + fr) * RW_P + 32 + 8 * fq) * 2), B1, a2); }
                if (I2 == J) {
#pragma unroll
                    for (int r = 0; r < 4; ++r) if (!(4 * fq + r <= fr)) { a1[r] = 0.f; a2[r] = 0.f; } }
                abr[I2] = pack4(a1); akr[I2] = a2; } }
    }
    __syncthreads();

    {   const int J = ct; float T[16];
#pragma unroll
        for (int t = 0; t < 16; ++t) { float acc = (fr == t) ? 1.f : 0.f;
#pragma unroll
            for (int i = 0; i < t; ++i) acc += T[i] * lds_f(lds, R_DG(0) + d * 16384 + ((J * 16 + i) * 16 + t) * 4);
            T[t] = acc; }
        if (fq == 0) {
#pragma unroll
            for (int t = 0; t < 16; ++t) *(LAS bf16_t*)(lds + R_TJ(0) + d * 16384 + ((J * 16 + t) * 24 + fr) * 2) = f2bf(T[t]); }
    }
    __syncthreads();

#pragma unroll
    for (int dd = 0; dd < 2; ++dd) {
        f32x4 R[4];
#pragma unroll
        for (int J = 0; J < 4; ++J) { if (w < 4) R[J] = unpack4(*(const LAS u32x2*)(lds + R_AT(0) + dd * 36864 + ((16 * J + fr) * RW_P + 16 * w + 4 * fq) * 2)); else R[J] = yak[dd][J]; }
        const int xrow = R_BT(0) + dd * 36864 + (16 * w + fr) * RW_P * 2;
#pragma unroll
        for (int J = 0; J < 4; ++J) {
            if (J >= 1) {
#pragma unroll
                for (int ks = 0; ks < (J + 1) / 2; ++ks) R[J] = MFMA32(LDS_B128(xrow + (32 * ks + 8 * fq) * 2), LDS_B128(R_AB(0) + dd * 16384 + ((16 * J + fr) * RW_P + 32 * ks + 8 * fq) * 2), R[J]); }
            CFENCE();
#pragma unroll
            for (int r = 0; r < 4; ++r) *(LAS bf16_t*)(lds + R_SCR + w * 768 + ((4 * fq + r) * 24 + fr) * 2) = f2bf(R[J][r]);
            CFENCE();
            const bf16x4s Ax = LDS_B64(R_SCR + w * 768 + (fr * 24 + 4 * fq) * 2), Bx = LDS_B64(R_TJ(0) + dd * 16384 + ((J * 16 + fr) * 24 + 4 * fq) * 2);
            const f32x4 X = MFMA16(Ax, Bx, ((f32x4){0.f, 0.f, 0.f, 0.f}));
            CFENCE();
#pragma unroll
            for (int r = 0; r < 4; ++r) *(LAS bf16_t*)(lds + R_BT(0) + dd * 36864 + ((16 * w + 4 * fq + r) * RW_P + 16 * J + fr) * 2) = f2bf(X[r]);
            CFENCE();
        }
    }
    __syncthreads();

    const int sc = (d == 0) ? tc : (isctx ? 3 - tc : 135 - tc);
    const size_t cidx = (size_t)((d * 32 + b * 8 + h) * RW_NCH + sc);
    if (MODE == 0) {
#pragma unroll
        for (int tt = 0; tt < 4; ++tt) { const int pos0 = d ? 63 - (16 * tt + 4 * fq + 3) : 16 * tt + 4 * fq;
            *(LAS u32x2*)(lds + R_AT(0) + d * 36864 + ((16 * ct + fr) * RW_P + pos0) * 2) = bhp[tt]; *(LAS u32x2*)(lds + R_AB(0) + d * 16384 + ((16 * ct + fr) * RW_P + pos0) * 2) = khp[tt]; }
        __syncthreads();
        const int BH = R_AT(0) + d * 36864, KH = R_AB(0) + d * 16384, XB = R_BT(0) + d * 36864, kt2 = ct;
        const bf16x8_t Bb0 = LDS_B128(BH + ((16 * kt2 + fr) * RW_P + 8 * fq) * 2), Bb1 = LDS_B128(BH + ((16 * kt2 + fr) * RW_P + 32 + 8 * fq) * 2);
        f32x4 Mt[4], Nt[4];
        const float wcv = lds_f(lds, R_WC(0) + d * 256 + (16 * kt2 + fr) * 4);
#pragma unroll
        for (int kt = 0; kt < 4; ++kt) { f32x4 acc = (f32x4){0.f, 0.f, 0.f, 0.f};
            if (kt == kt2) {
#pragma unroll
                for (int r = 0; r < 4; ++r) if (4 * fq + r == fr) acc[r] = wcv; }
            acc = MFMA32(LDS_B128(XB + ((16 * kt + fr) * RW_P + 8 * fq) * 2), Bb0, acc); acc = MFMA32(LDS_B128(XB + ((16 * kt + fr) * RW_P + 32 + 8 * fq) * 2), Bb1, acc); Mt[kt] = acc;
            f32x4 an = unpack4(*(const LAS u32x2*)(lds + KH + ((16 * kt2 + fr) * RW_P + 16 * kt + 4 * fq) * 2));
            an = MFMA32(LDS_B128(XB + ((64 + 16 * kt + fr) * RW_P + 8 * fq) * 2), Bb0, an); an = MFMA32(LDS_B128(XB + ((64 + 16 * kt + fr) * RW_P + 32 + 8 * fq) * 2), Bb1, an); Nt[kt] = an; }
        unsigned char* ma = RG.MA + cidx * 8192;
#pragma unroll
        for (int s = 0; s < 2; ++s) *(bf16x8_t*)(ma + ((kt2 * 2 + s) * 64 + lane) * 16) = pack8(Mt[2 * s], Mt[2 * s + 1]);
        unsigned char* zt = (d == 0 ? RG.ZT0 : RG.ZT1) + (cidx - (size_t)d * 32 * RW_NCH) * 8192;
        const bf16x8_t An0 = pack8(Nt[0], Nt[1]), An1 = pack8(Nt[2], Nt[3]);
        const int VT = R_VT(0) + d * 9216;
#pragma unroll
        for (int vt = 0; vt < 4; ++vt) { f32x4 z = (f32x4){0.f, 0.f, 0.f, 0.f}; const int vo = VT + ((16 * vt + fr) * RW_P + 4 * fq) * 2;
            z = MFMA32(An0, join8(LDS_B64(vo), LDS_B64(vo + 32)), z); z = MFMA32(An1, join8(LDS_B64(vo + 64), LDS_B64(vo + 96)), z);
            *(u32x2*)(zt + ((kt2 * 4 + vt) * 64 + lane) * 8) = pack4(z); }
    } else {
        const int J = ct;
#pragma unroll
        for (int I2 = 0; I2 < 4; ++I2) *(LAS u32x2*)(lds + R_AT(0) + d * 36864 + ((16 * J + fr) * RW_P + 16 * I2 + 4 * fq) * 2) = abr[I2];
        __syncthreads();
        const int ABR = R_AT(0) + d * 36864, XB = R_BT(0) + d * 36864, RT = R_RT(0) + d * 36864;
        const bf16x8_t Bb0 = LDS_B128(ABR + ((16 * J + fr) * RW_P + 8 * fq) * 2), Bb1 = LDS_B128(ABR + ((16 * J + fr) * RW_P + 32 + 8 * fq) * 2);
        f32x4 Qt[4], Gt[4];
#pragma unroll
        for (int kt = 0; kt < 4; ++kt) { f32x4 acc = unpack4(*(const LAS u32x2*)(lds + RT + ((16 * J + fr) * RW_P + 16 * kt + 4 * fq) * 2));
            acc = MFMA32(LDS_B128(XB + ((16 * kt + fr) * RW_P + 8 * fq) * 2), Bb0, acc); acc = MFMA32(LDS_B128(XB + ((16 * kt + fr) * RW_P + 32 + 8 * fq) * 2), Bb1, acc); Qt[kt] = acc;
            f32x4 ag = akr[kt];
            ag = MFMA32(LDS_B128(XB + ((64 + 16 * kt + fr) * RW_P + 8 * fq) * 2), Bb0, ag); ag = MFMA32(LDS_B128(XB + ((64 + 16 * kt + fr) * RW_P + 32 + 8 * fq) * 2), Bb1, ag); Gt[kt] = ag; }
        const bf16x8_t Aq0 = pack8(Qt[0], Qt[1]), Aq1 = pack8(Qt[2], Qt[3]), Ag0 = pack8(Gt[0], Gt[1]), Ag1 = pack8(Gt[2], Gt[3]);
        const unsigned char* scp = RG.SC + cidx * 8192; const int VT = R_VT(0) + d * 9216;
        f32x4 Ot[4];
#pragma unroll
        for (int vt = 0; vt < 4; ++vt) { f32x4 o = (f32x4){0.f, 0.f, 0.f, 0.f}; const int vo = VT + ((16 * vt + fr) * RW_P + 4 * fq) * 2;
            o = MFMA32(Aq0, *(const bf16x8_t*)(scp + ((vt * 2 + 0) * 64 + lane) * 16), o); o = MFMA32(Aq1, *(const bf16x8_t*)(scp + ((vt * 2 + 1) * 64 + lane) * 16), o);
            o = MFMA32(Ag0, join8(LDS_B64(vo), LDS_B64(vo + 32)), o); o = MFMA32(Ag1, join8(LDS_B64(vo + 64), LDS_B64(vo + 96)), o); Ot[vt] = o; }
        __syncthreads();
#pragma unroll
        for (int vt = 0; vt < 4; ++vt)
#pragma unroll
            for (int r = 0; r < 4; ++r) { const int pos = 16 * J + 4 * fq + r, tok = d ? 63 - pos : pos; *(LAS float*)(lds + R_OX + ((d * 64 + tok) * 65 + 16 * vt + fr) * 4) = Ot[vt][r]; }
        __syncthreads();
        {   const int tok = tid >> 3, c0 = (tid & 7) * 8; float o[8]; float s = 0.f;
#pragma unroll
            for (int j = 0; j < 8; ++j) { o[j] = lds_f(lds, R_OX + (tok * 65 + c0 + j) * 4) + lds_f(lds, R_OX + ((64 + tok) * 65 + c0 + j) * 4); s += o[j]; }
            s += __shfl_xor(s, 1); s += __shfl_xor(s, 2); s += __shfl_xor(s, 4); const float mu = s * (1.f / 64.f); float q = 0.f;
#pragma unroll
            for (int j = 0; j < 8; ++j) { const float dl = o[j] - mu; q += dl * dl; }
            q += __shfl_xor(q, 1); q += __shfl_xor(q, 2); q += __shfl_xor(q, 4); const float rs = rsqrtf(q * (1.f / 64.f) + 64e-5f);
            float bc = 0.f;
#pragma unroll
            for (int i = 0; i < 8; ++i) bc += lds_f(lds, R_BCP + (i * 64 + tok) * 4);
            unsigned pk[4];
#pragma unroll
            for (int j = 0; j < 8; j += 2) { float y[2];
#pragma unroll
                for (int e = 0; e < 2; ++e) { const int c = c0 + j + e; const float vv = bf2f(*(const LAS bf16_t*)(lds + R_VT(0) + (c * RW_P + tok) * 2)), gg = bf2f(*(const LAS bf16_t*)(lds + R_GG + (tok * GGP + c) * 2));
                    y[e] = ((o[j + e] - mu) * rs * ln_g[h * 64 + c] + ln_b[h * 64 + c] + bc * vv) * gg; }
                pk[j >> 1] = pg8::cvt_pk_bf16(y[0], y[1]); }
            bf16_t* mix = (bf16_t*)(p.ws + WS_BUF0);
            *(u32x4*)(mix + (size_t)(base_row + tok) * DM + h * 64 + c0) = (u32x4){pk[0], pk[1], pk[2], pk[3]}; }
    }
    __syncthreads();
}

template <int MODE>
__device__ __forceinline__ void ph_rwkv(const MP& p, int bid, int nblk, LAS unsigned char* lds) {
    constexpr int NU = NB * RW_NCH * 8;
    for (int u = bid; u < NU; u += nblk) rwkv_unit<MODE>(p, u, lds);
}

__device__ __forceinline__ void ph_rwkv_scan2(const MP& p, int bid, int nblk) {
    if (threadIdx.x >= 64) return;
    const RwkvG RG = mk_rwkvg(p); const int lane = threadIdx.x;
    for (int task = bid; task < 256; task += nblk) {
        const int chain = (task & 7) + 8 * (task >> 5), vt = (task >> 3) & 3;
        const unsigned char* ma = RG.MA + (size_t)chain * RW_NCH * 8192;
        const unsigned char* zt = (chain < 32 ? RG.ZT0 + (size_t)chain * RW_NCH * 8192 : RG.ZT1 + (size_t)(chain - 32) * RW_NCH * 8192);
        unsigned char* scp = RG.SC + (size_t)chain * RW_NCH * 8192;
        f32x4 St[4];
#pragma unroll
        for (int k = 0; k < 4; ++k) St[k] = (f32x4){0.f, 0.f, 0.f, 0.f};
        bf16x8_t mA[4][2], nA[4][2]; u32x2 zA[4], nz[4];
#pragma unroll
        for (int k = 0; k < 4; ++k) { zA[k] = *(const u32x2*)(zt + ((k * 4 + vt) * 64 + lane) * 8); nz[k] = zA[k];
#pragma unroll
            for (int s = 0; s < 2; ++s) { mA[k][s] = *(const bf16x8_t*)(ma + ((k * 2 + s) * 64 + lane) * 16); nA[k][s] = mA[k][s]; } }
        for (int c = 0; c < RW_NCH; ++c) {
            if (c + 1 < RW_NCH) { const unsigned char* ma2 = ma + (size_t)(c + 1) * 8192; const unsigned char* zt2 = zt + (size_t)(c + 1) * 8192;
#pragma unroll
                for (int k = 0; k < 4; ++k) { nz[k] = *(const u32x2*)(zt2 + ((k * 4 + vt) * 64 + lane) * 8);
#pragma unroll
                    for (int s = 0; s < 2; ++s) nA[k][s] = *(const bf16x8_t*)(ma2 + ((k * 2 + s) * 64 + lane) * 16); } }
            const bf16x8_t B0 = pack8(St[0], St[1]), B1 = pack8(St[2], St[3]);
            unsigned char* so = scp + (size_t)c * 8192;
            *(bf16x8_t*)(so + ((vt * 2 + 0) * 64 + lane) * 16) = B0; *(bf16x8_t*)(so + ((vt * 2 + 1) * 64 + lane) * 16) = B1;
#pragma unroll
            for (int k = 0; k < 4; ++k) { f32x4 acc = unpack4(zA[k]); acc = MFMA32(mA[k][0], B0, acc); acc = MFMA32(mA[k][1], B1, acc); St[k] = acc; }
#pragma unroll
            for (int k = 0; k < 4; ++k) { zA[k] = nz[k]; mA[k][0] = nA[k][0]; mA[k][1] = nA[k][1]; }
        }
    }
}

constexpr size_t WS_VTL = WS_WTL0 + (size_t)26 * 1024 * 1024;
constexpr size_t WS_VTC = WS_SLOC;
static_assert(WS_WT + WT_L0END <= WS_VTL && WS_VTL + (size_t)32 * 64 * 8192 * 2 <= WS_SLOC, "VT layout");

template <bool WIN>
__device__ __forceinline__ void na_block(const bf16_t* __restrict__ p0, const bf16_t* __restrict__ vt, const LAS float* rpbl, const bf16x8_t (&Qf)[2], f32x4 (&O)[4], float& m_run, float& l_run,
                                         int krow0  , int h, size_t vtrow  , int vtld,
                                         int rq_minus_r0  , int cq, int cs, int fr, int fq) {
    f32x4 S[16];
#pragma unroll
    for (int ti = 0; ti < 16; ++ti) { const int krow = WIN ? krow0 + (ti >> 1) * 64 + (ti & 1) * 16 + fr : krow0 + 16 * ti + fr;
        const bf16_t* kp = p0 + (size_t)krow * NIN0 + 2304 + h * 64 + 8 * fq;
        f32x4 acc = (f32x4){0.f, 0.f, 0.f, 0.f};
        acc = MFMA32(*(const bf16x8_t*)kp, Qf[0], acc); acc = MFMA32(*(const bf16x8_t*)(kp + 32), Qf[1], acc);
        S[ti] = acc; }
    float mx = -1e30f;
    if (WIN) { const int c0q = min(max(cq - 8, 0), 48);
#pragma unroll
        for (int ti = 0; ti < 16; ++ti) { const int kr = ti >> 1; const int rr = kr - rq_minus_r0 + 7;
#pragma unroll
            for (int r = 0; r < 4; ++r) { const int kc = cs + (ti & 1) * 16 + 4 * fq + r; const bool ok = kc >= c0q && kc <= c0q + 15;
                const float bias = ok ? rpbl[rr * 31 + (kc - cq + 15)] : 0.f;
                const float s = ok ? S[ti][r] * 0.125f + bias : -1e30f; S[ti][r] = s; mx = fmaxf(mx, s); } }
    } else {
#pragma unroll
        for (int ti = 0; ti < 16; ++ti)
#pragma unroll
            for (int r = 0; r < 4; ++r) { const float s = S[ti][r] * 0.125f; S[ti][r] = s; mx = fmaxf(mx, s); } }
    mx = fmaxf(mx, __shfl_xor(mx, 16)); mx = fmaxf(mx, __shfl_xor(mx, 32));
    const float m_new = fmaxf(m_run, mx), sc = __expf(m_run - m_new);
    float ls = 0.f;
#pragma unroll
    for (int ti = 0; ti < 16; ++ti)
#pragma unroll
        for (int r = 0; r < 4; ++r) { const float pv = __expf(S[ti][r] - m_new); S[ti][r] = pv; ls += pv; }
    ls += __shfl_xor(ls, 16); ls += __shfl_xor(ls, 32);
    l_run = l_run * sc + ls; m_run = m_new;
#pragma unroll
    for (int dt = 0; dt < 4; ++dt) O[dt] = O[dt] * sc;
#pragma unroll
    for (int s = 0; s < 8; ++s) { const bf16x8_t Pb = pack8(S[2 * s], S[2 * s + 1]);
        const size_t ko = WIN ? (size_t)s * 64 + 4 * fq : (size_t)s * 32 + 4 * fq;
#pragma unroll
        for (int dt = 0; dt < 4; ++dt) { const bf16_t* vp = vt + vtrow + (size_t)(16 * dt + fr) * vtld + ko;
            const bf16x8_t Av = join8(*(const bf16x4_t*)vp, *(const bf16x4_t*)(vp + 16));
            O[dt] = MFMA32(Av, Pb, O[dt]); } }
}

__device__ __forceinline__ void ph_na2(const MP& p, int bid, int nblk, LAS unsigned char* lds) {
    const bf16_t* __restrict__ p0 = (const bf16_t*)(p.ws + WS_BIG); const bf16_t* vtl = (const bf16_t*)(p.ws + WS_VTL); const bf16_t* vtc = (const bf16_t*)(p.ws + WS_VTC);
    const float* rpb = p.in[24]; bf16_t* mix = (bf16_t*)(p.ws + WS_BUF0);
    int tid_ = threadIdx.x; asm volatile("" : "+v"(tid_));
    const int tid = tid_, w = __builtin_amdgcn_readfirstlane(tid >> 6), lane = tid & 63, fr = lane & 15, fq = lane >> 4;
    LAS float* rpbl = (LAS float*)(lds + w * 2048);
    const int gw = bid * 8 + w, NW = nblk * 8;
    constexpr int NLAT = NB * 8 * 128 * 4, NCTXT = NB * 8 * 16;
    int hcur = -1;
    for (int t0 = gw * 8; t0 < NLAT + NCTXT * 8; t0 += NW * 8) {
#pragma unroll 1
        for (int ti8 = 0; ti8 < 8; ++ti8) { const int task = t0 + ti8;
            int b, h, qrow0; bool lat; int rq = 0, j = 0;
            if (task < NLAT) { lat = true; j = task & 3; rq = (task >> 2) & 127; h = (task >> 9) & 7; b = task >> 12; qrow0 = b * TL + rq * 64 + 16 * j; }
            else { const int tc = task - NLAT; if ((tc & 7) != 0 || (tc >> 3) >= NCTXT) continue; const int t2 = tc >> 3; lat = false; const int qt = t2 & 15; h = (t2 >> 4) & 7; b = t2 >> 7; qrow0 = MLAT + b * LC + 16 * qt; }
            if (h != hcur) { for (int i = lane; i < 465; i += 64) rpbl[i] = rpb[h * 465 + i]; hcur = h; }
            bf16x8_t Qf[2];
            { const bf16_t* qp = p0 + (size_t)(qrow0 + fr) * NIN0 + 1792 + h * 64 + 8 * fq; Qf[0] = *(const bf16x8_t*)qp; Qf[1] = *(const bf16x8_t*)(qp + 32); }
            f32x4 O[4];
#pragma unroll
            for (int dt = 0; dt < 4; ++dt) O[dt] = (f32x4){0.f, 0.f, 0.f, 0.f};
            float m_run = -1e30f, l_run = 0.f;
            const int bh = b * 8 + h;
            if (lat) { const int r0 = min(max(rq - 4, 0), 120); const int cs = (j == 0) ? 0 : (j == 1 ? 8 : (j == 2 ? 24 : 32));
                na_block<true>(p0, vtl, rpbl, Qf, O, m_run, l_run, b * TL + r0 * 64 + cs, h, (size_t)bh * 64 * TL + (size_t)r0 * 64 + cs, TL, rq - r0, 16 * j + fr, cs, fr, fq); }
            na_block<false>(p0, vtc, rpbl, Qf, O, m_run, l_run, MLAT + b * LC, h, (size_t)bh * 64 * LC, LC, 0, 0, 0, fr, fq);
            const float inv = 1.f / l_run;
#pragma unroll
            for (int dt = 0; dt < 4; ++dt) { const f32x4 o = O[dt] * inv; *(u32x2*)(mix + (size_t)(qrow0 + fr) * DM + 512 + h * 64 + 16 * dt + 4 * fq) = pack4(o); }
        }
    }
}


__device__ __forceinline__ void ph_adaln(const MP& p, int bid, int nblk, char* lds) {
    const float* c = p.in[1]; const float* c_ctx = p.in[3]; const float* ada_w = p.in[6]; const float* ada_b = p.in[7]; const float* hg_lower = p.in[27];
    float* mod = (float*)(p.ws + WS_MOD); float* lb = (float*)(p.ws + WS_LB);
    float* s = (float*)lds; float* red = s + 5 * 1024;
    const int tid = threadIdx.x;
    __syncthreads();
    for (int i = tid; i < 5 * 1024; i += 512) { const int mb = i >> 10, k = i & 1023; const float x = mb < 4 ? c[mb * 1024 + k] : c_ctx[k]; s[i] = siluf_(x); }
    __syncthreads();
    for (int it = bid; it < 2 * 96; it += nblk) { const int l = it / 96, n0 = (it % 96) * 64;
        gemv5_item(ada_w + (size_t)l * 1024 * 6144, 6144, n0, s, red, mod + (size_t)l * 5 * 6144, 6144, ada_b + l * 6144); }
    if (bid == nblk - 1) for (int k = tid; k < 1024; k += 512) lb[k] = sigmoidf_(hg_lower[1024 + k] - hg_lower[k]);
    __syncthreads();
}
__device__ __forceinline__ void ph_wt(const MP& p, int bid, int nblk, char* lds) {
    const float* w_in0 = p.in[10]; const float* w_out0 = p.in[11]; const float* w1 = p.in[8]; const float* w2 = p.in[9]; const float* w_in1 = p.in[25]; const float* w_out1 = p.in[26];
    char* wt = p.ws + WS_WT;
    const int tid = threadIdx.x, w = tid >> 6, lane = tid & 63;
    float* scr = (float*)lds + w * 64 * 33;
    const int gw = bid * 8 + w, NGW = nblk * 8;
    __syncthreads();
#define WT_JOB(Wp, K_, N_, off_) { const int nitems = ((K_) / 64) * ((N_) / 32); for (int it = gw; it < nitems; it += NGW) transpose_item((Wp), (K_), (N_), (bf16_t*)(wt + (off_)), scr, it, lane); }
    WT_JOB(w_in0, 1024, NIN0, WT_IN0) WT_JOB(w_out0, 1024, 1024, WT_OUT0) WT_JOB(w1, 1024, NHID, WT_W10) WT_JOB(w2, NHID, 1024, WT_W20)
    WT_JOB(w_in1, 1024, NIN1, WT_IN1) WT_JOB(w_out1, 1024, 1024, WT_OUT1) WT_JOB(w1 + (size_t)1024 * NHID, 1024, NHID, WT_W11) WT_JOB(w2 + (size_t)NHID * 1024, NHID, 1024, WT_W21)
#undef WT_JOB
    __syncthreads();
}
__device__ __forceinline__ void ph_gs(const MP& p, int bid, int nblk) {
    const float* mod = (const float*)(p.ws + WS_MOD); const float* norm_mix_g = p.in[4]; const float* norm_mlp_g = p.in[5]; float* gs = (float*)(p.ws + WS_GS);
    for (int i = bid * 512 + threadIdx.x; i < 4 * 5 * 1024; i += nblk * 512) {
        const int w = i / 5120, mb = (i / 1024) % 5, k = i & 1023, l = w >> 1, second = w & 1;
        const float g = second ? norm_mlp_g[l * 1024 + k] : norm_mix_g[l * 1024 + k];
        const float sc = mod[(size_t)(l * 5 + mb) * 6144 + (second ? 4 * 1024 : 1024) + k];
        gs[i] = g * (1.f + sc); }
}
__device__ __forceinline__ void ph_shw(const MP& p, int bid, int nblk, char* lds) {
    const float* mod = (const float*)(p.ws + WS_MOD); const float* w_in0 = p.in[10]; const float* w1 = p.in[8]; const float* w_in1 = p.in[25];
    float* s = (float*)lds; float* red = s + 5 * 1024;
    const int tid = threadIdx.x;
    int cur = -1;
    for (int it = bid; it < 52 + 64 + 80 + 64; it += nblk) {
        int which, n0; const float* W; int ldw; float* out;
        if (it < 52) { which = 0; n0 = it * 64; W = w_in0; ldw = NIN0; out = (float*)(p.ws + WS_SHW0); }
        else if (it < 116) { which = 1; n0 = (it - 52) * 64; W = w1; ldw = NHID; out = (float*)(p.ws + WS_SHW1); }
        else if (it < 196) { which = 2; n0 = (it - 116) * 64; W = w_in1; ldw = NIN1; out = (float*)(p.ws + WS_SHW2); }
        else { which = 3; n0 = (it - 196) * 64; W = w1 + (size_t)1024 * NHID; ldw = NHID; out = (float*)(p.ws + WS_SHW3); }
        if (which != cur) { __syncthreads(); const int l = which >> 1, off = (which & 1) ? 3 * 1024 : 0;
            for (int i = tid; i < 5 * 1024; i += 512) { const int mb = i >> 10, k = i & 1023; s[i] = mod[(size_t)(l * 5 + mb) * 6144 + off + k]; }
            __syncthreads(); cur = which; }
        gemv5_item(W, ldw, n0, s, red, out, ldw, nullptr);
    }
    __syncthreads();
}
__device__ __forceinline__ void ph_norm_in(const MP& p, int bid, int nblk) {
    const float* x = p.in[0]; const float* ctx = p.in[2]; const float* ng = p.in[4]; const float* mod = (const float*)(p.ws + WS_MOD);
    bf16_t* xb = (bf16_t*)(p.ws + WS_BUF0); float* ssq = (float*)(p.ws + WS_SSQ);
    const int w = threadIdx.x >> 6, lane = threadIdx.x & 63;
    for (int row = bid * 8 + w; row < MALL; row += nblk * 8) {
        const float* xr = row < MLAT ? x + (size_t)row * DM : ctx + (size_t)(row - MLAT) * DM;
        const int mb = row < MLAT ? row >> 13 : 4;
        const f32x4* x4 = (const f32x4*)xr + lane; const f32x4* g4 = (const f32x4*)ng + lane; const f32x4* s4 = (const f32x4*)(mod + (size_t)mb * 6144 + 1024) + lane;
        f32x4 v[4]; float s = 0.f;
#pragma unroll
        for (int j = 0; j < 4; ++j) { v[j] = x4[64 * j]; s += (v[j].x * v[j].x + v[j].y * v[j].y) + (v[j].z * v[j].z + v[j].w * v[j].w); }
        s = wave_sum(s);
        u32x2* o = (u32x2*)(xb + (size_t)row * DM) + lane;
#pragma unroll
        for (int j = 0; j < 4; ++j) { const f32x4 g = g4[64 * j] * (s4[64 * j] + 1.f); u32x2 pk; pk.x = pk2(v[j].x * g.x, v[j].y * g.y); pk.y = pk2(v[j].z * g.z, v[j].w * g.w); o[64 * j] = pk; }
        if (lane < 16) ssq[(size_t)row * 16 + lane] = lane == 0 ? s : 0.f;
    }
}
__device__ __forceinline__ void ph_final(const MP& p, int bid, int nblk) {
    float* out = p.out; const float* ssq = (const float*)(p.ws + WS_SSQ); const float* g = p.in[29];
    const int w = threadIdx.x >> 6, lane = threadIdx.x & 63;
    for (int row = bid * 8 + w; row < MLAT; row += nblk * 8) {
        float s = lane < 16 ? ssq[(size_t)row * 16 + lane] : 0.f; s = wave_sum(s);
        const float rstd = rsqrtf(s * (1.f / 1024.f) + NORM_EPS);
        f32x4* o4 = (f32x4*)(out + (size_t)row * DM) + lane; const f32x4* g4 = (const f32x4*)g + lane;
#pragma unroll
        for (int j = 0; j < 4; ++j) { f32x4 v = o4[64 * j]; const f32x4 gg = g4[64 * j]; v = v * rstd * gg; o4[64 * j] = v; }
    }
}

__device__ __forceinline__ RwkvW mk_rwkvw(const MP& p) {
    RwkvW W; W.mu_prev = p.in[12]; W.mu_next = p.in[13]; W.w0 = p.in[14]; W.w_up = p.in[15]; W.a0 = p.in[16]; W.a_up = p.in[17]; W.g_up = p.in[18]; W.k_k = p.in[19]; W.k_a = p.in[20]; W.r_k = p.in[21]; W.ln_g = p.in[22]; W.ln_b = p.in[23]; return W; }
__device__ __forceinline__ RwkvTmp mk_rwkvtmp(const MP& p) {
    const size_t RH = (size_t)2 * (TL + LC), AB = RH * 512 * 2, AF = RH * 512 * 4;
    char* t0 = (char*)p.out; char* t1 = p.ws + WS_BIG + BIG_P0END;
    RwkvTmp T; T.lw0 = (float*)t0; T.lw1 = (float*)(t0 + AF); T.osum = (float*)(t0 + 2 * AF); T.r = (bf16_t*)(t0 + 3 * AF);
    T.k = (bf16_t*)t1; T.v = (bf16_t*)(t1 + AB); T.kk = (bf16_t*)(t1 + 2 * AB); T.a0 = (bf16_t*)(t1 + 3 * AB); T.a1 = (bf16_t*)(t1 + 4 * AB); T.g = (bf16_t*)(t1 + 5 * AB); return T; }
constexpr int PREP_TOK = 8;
__device__ __forceinline__ void ph_rwkv_prep(const MP& p, int bid, int nblk, char* lds, int b0) {
    const int nbh = 2; const bf16_t* p0 = (const bf16_t*)(p.ws + WS_BIG); const RwkvW W = mk_rwkvw(p); const RwkvTmp T = mk_rwkvtmp(p); float* bc = (float*)(p.ws + WS_BC);
    float (*lin)[256] = (float (*)[256])lds;
    const int tid = threadIdx.x, lane = tid & 63;
    const int nrows = nbh * (TL + LC);
    { f32x4* z = (f32x4*)T.osum; const size_t n4 = (size_t)nrows * 512 / 4; for (size_t i = (size_t)bid * 512 + tid; i < n4; i += (size_t)nblk * 512) z[i] = (f32x4){0.f, 0.f, 0.f, 0.f}; }
    for (int base = bid * PREP_TOK; base < nrows; base += nblk * PREP_TOK) {
        __syncthreads();
        if (tid < 256) { const int col = 1536 + tid; const float mup = W.mu_prev[col], mun = W.mu_next[col];
#pragma unroll
            for (int tk = 0; tk < PREP_TOK; ++tk) { int grow, t, slen; lrow_info(base + tk, b0, nbh, grow, t, slen);
                const float x = shifted(p0, grow, t, slen, col, mup, mun);
                lin[tk][tid] = tid < 64 ? tanhf(x) : (tid < 128 ? x : sigmoidf_(x)); } }
        __syncthreads();
        { const int c = tid;
            float wl0[PREP_TOK], wl1[PREP_TOK], av0[PREP_TOK], av1[PREP_TOK], gv[PREP_TOK];
#pragma unroll
            for (int tk = 0; tk < PREP_TOK; ++tk) { wl0[tk] = W.w0[c]; wl1[tk] = W.w0[512 + c]; av0[tk] = W.a0[c]; av1[tk] = W.a0[512 + c]; gv[tk] = 0.f; }
#pragma unroll 4
            for (int j = 0; j < 64; ++j) { const float u0 = W.w_up[(size_t)j * 512 + c], u1 = W.w_up[(size_t)(64 + j) * 512 + c], q0 = W.a_up[(size_t)j * 512 + c], q1 = W.a_up[(size_t)(64 + j) * 512 + c];
#pragma unroll
                for (int tk = 0; tk < PREP_TOK; ++tk) { const float tl = lin[tk][j], al = lin[tk][64 + j]; wl0[tk] += tl * u0; wl1[tk] += tl * u1; av0[tk] += al * q0; av1[tk] += al * q1; } }
#pragma unroll 4
            for (int j = 0; j < 128; ++j) { const float gu = W.g_up[(size_t)j * 512 + c];
#pragma unroll
                for (int tk = 0; tk < PREP_TOK; ++tk) gv[tk] += lin[tk][128 + j] * gu; }
            const float mpr = W.mu_prev[c], mnr = W.mu_next[c], mpk = W.mu_prev[512 + c], mnk = W.mu_next[512 + c], mpv = W.mu_prev[1024 + c], mnv = W.mu_next[1024 + c];
            const float kkc = W.k_k[c], kac = W.k_a[c], rkc = W.r_k[c];
#pragma unroll
            for (int tk = 0; tk < PREP_TOK; ++tk) { int grow, t, slen; lrow_info(base + tk, b0, nbh, grow, t, slen);
                const float r = shifted(p0, grow, t, slen, c, mpr, mnr), k = shifted(p0, grow, t, slen, 512 + c, mpk, mnk), v = shifted(p0, grow, t, slen, 1024 + c, mpv, mnv);
                const float sp0 = wl0[tk] > 15.f ? 0.f : log1pf(__expf(-wl0[tk])), sp1 = wl1[tk] > 15.f ? 0.f : log1pf(__expf(-wl1[tk]));
                const float lw0 = -__expf(-(wl0[tk] < -15.f ? -wl0[tk] : sp0) - 0.5f), lw1 = -__expf(-(wl1[tk] < -15.f ? -wl1[tk] : sp1) - 0.5f);
                const float a0 = sigmoidf_(av0[tk]), a1 = sigmoidf_(av1[tk]);
                float kk = k * kkc; const float n2 = wave_sum(kk * kk); kk = kk / fmaxf(sqrtf(n2), 1e-12f);
                const float kd0 = k * (1.f + (a0 - 1.f) * kac), kd1 = k * (1.f + (a1 - 1.f) * kac);
                const float bsum = wave_sum(r * rkc * (kd0 + kd1));
                const size_t o = (size_t)(base + tk) * 512 + c;
                T.r[o] = f2bf(r); T.k[o] = f2bf(k); T.v[o] = f2bf(v); T.kk[o] = f2bf(kk); T.a0[o] = f2bf(a0); T.a1[o] = f2bf(a1); T.g[o] = f2bf(gv[tk]); T.lw0[o] = lw0; T.lw1[o] = lw1;
                if (lane == 0) bc[(size_t)grow * 8 + (c >> 6)] = bsum; }
        }
    }
    __syncthreads();
}
__device__ __forceinline__ void ph_rwkv_scan(const MP& p, int bid) {
    const int nbh = 2; const RwkvTmp T = mk_rwkvtmp(p); const float* k_a = p.in[20];
    const int chain = bid * 2 + (threadIdx.x >> 8), dir = chain / (nbh * 8), lb = (chain / 8) % nbh, h = chain & 7;
    const int tid = threadIdx.x & 255, v = tid >> 2, kq = tid & 3;
    float S[16], ka[16];
#pragma unroll
    for (int i = 0; i < 16; ++i) { S[i] = 0.f; ka[i] = k_a[h * 64 + kq * 16 + i]; }
    const int nsteps = LC + TL;
    auto lrow_of = [&](int s) -> size_t { if (s < LC) { const int t = dir ? LC - 1 - s : s; return (size_t)nbh * TL + lb * LC + t; } const int s2 = s - LC; const int t = dir ? TL - 1 - s2 : s2; return (size_t)lb * TL + t; };
    ScanIn cur, nxt; scan_load(cur, T, dir, lrow_of(0), h, v, kq);
    for (int s = 0; s < nsteps; ++s) {
        const size_t lrow = lrow_of(s);
        if (s + 1 < nsteps) scan_load(nxt, T, dir, lrow_of(s + 1), h, v, kq); else nxt = cur;
        float r[16], k[16], kk[16], a[16], w[16];
#pragma unroll
        for (int i = 0; i < 16; ++i) { const int q = i >> 3, j = (i >> 1) & 3, hi = i & 1; r[i] = bfu(cur.r[q][j], hi); k[i] = bfu(cur.k[q][j], hi); kk[i] = bfu(cur.kk[q][j], hi); a[i] = bfu(cur.a[q][j], hi); w[i] = __expf(cur.lw[i >> 2][i & 3]); }
        float skk = 0.f;
#pragma unroll
        for (int i = 0; i < 16; ++i) skk += S[i] * kk[i];
        skk += __shfl_xor(skk, 1); skk += __shfl_xor(skk, 2);
        float o = 0.f;
#pragma unroll
        for (int i = 0; i < 16; ++i) { const float kd = k[i] * (1.f + (a[i] - 1.f) * ka[i]); S[i] = S[i] * w[i] - skk * (kk[i] * a[i]) + cur.v * kd; o += S[i] * r[i]; }
        o += __shfl_xor(o, 1); o += __shfl_xor(o, 2);
        if (kq == 0) atomicAdd(T.osum + lrow * 512 + h * 64 + v, o);
        cur = nxt;
    }
}
__device__ __forceinline__ void ph_rwkv_post(const MP& p, int bid, int nblk, int b0) {
    const int nbh = 2; const RwkvTmp T = mk_rwkvtmp(p); const float* bc = (const float*)(p.ws + WS_BC); const float* ln_g = p.in[22]; const float* ln_b = p.in[23]; bf16_t* mix = (bf16_t*)(p.ws + WS_BUF0);
    const int w = threadIdx.x >> 6, lane = threadIdx.x & 63; const int nrows = nbh * (TL + LC);
    for (int lr = bid * 8 + w; lr < nrows; lr += nblk * 8) { int grow, t, slen; lrow_info(lr, b0, nbh, grow, t, slen);
        const float* op = T.osum + (size_t)lr * 512 + lane * 8; float o[8]; float s = 0.f;
#pragma unroll
        for (int i = 0; i < 8; ++i) { o[i] = op[i]; s += o[i]; }
        s += __shfl_xor(s, 1); s += __shfl_xor(s, 2); s += __shfl_xor(s, 4); const float mu = s * (1.f / 64.f); float q = 0.f;
#pragma unroll
        for (int i = 0; i < 8; ++i) { const float d = o[i] - mu; q += d * d; }
        q += __shfl_xor(q, 1); q += __shfl_xor(q, 2); q += __shfl_xor(q, 4); const float rs = rsqrtf(q * (1.f / 64.f) + 64e-5f);
        const float bcv = bc[(size_t)grow * 8 + (lane >> 3)]; unsigned pk[4];
#pragma unroll
        for (int i = 0; i < 8; i += 2) { float y[2];
#pragma unroll
            for (int e = 0; e < 2; ++e) { const int c = lane * 8 + i + e; const float vv = bf2f(T.v[(size_t)lr * 512 + c]), gg = bf2f(T.g[(size_t)lr * 512 + c]);
                y[e] = ((o[i + e] - mu) * rs * ln_g[c] + ln_b[c] + bcv * vv) * gg; }
            pk[i >> 1] = pk2(y[0], y[1]); }
        u32x4 st; st.x = pk[0]; st.y = pk[1]; st.z = pk[2]; st.w = pk[3];
        *(u32x4*)(mix + (size_t)grow * DM + lane * 8) = st;
    }
}

__device__ __forceinline__ void ph_na(const MP& p, int bid, int nblk, char* lds, int t_lo, int t_hi) {
    const bf16_t* p0 = (const bf16_t*)(p.ws + WS_BIG); const float* rpb = p.in[24]; bf16_t* mix = (bf16_t*)(p.ws + WS_BUF0);
    float (*pbuf)[384] = (float (*)[384])lds;
    const int w = threadIdx.x >> 6, lane = threadIdx.x & 63;
    for (int task = t_lo + bid * 8 + w; task < t_hi; task += nblk * 8) {
        const int grow = task >> 3, h = task & 7;
        const bool lat = grow < MLAT;
        const int b = lat ? grow >> 13 : (grow - MLAT) >> 8;
        const int tq = lat ? grow & 8191 : 0, rq = tq >> 6, cq = tq & 63;
        const int r0 = min(max(rq - 4, 0), 120), c0 = min(max(cq - 8, 0), 48);
        const int nkeys = lat ? 384 : 256;
        float q[64];
        { const u32x4* qp = (const u32x4*)(p0 + (size_t)grow * NIN0 + 1792 + h * 64);
#pragma unroll
          for (int i = 0; i < 8; ++i) { const u32x4 x = qp[i];
#pragma unroll
              for (int j = 0; j < 4; ++j) { q[i * 8 + 2 * j] = bfu(x[j], 0); q[i * 8 + 2 * j + 1] = bfu(x[j], 1); } } }
        float sc[6]; float mx = -1e30f;
#pragma unroll
        for (int jj = 0; jj < 6; ++jj) { const int j = jj * 64 + lane; sc[jj] = -1e30f;
            if (j < nkeys) { int krow; float bias = 0.f;
                if (lat && j < 128) { const int kr = j >> 4, kc = j & 15; krow = b * TL + (r0 + kr) * 64 + c0 + kc; bias = rpb[(h * 15 + (r0 + kr - rq + 7)) * 31 + (c0 + kc - cq + 15)]; }
                else { const int l = lat ? j - 128 : j; krow = MLAT + b * LC + l; }
                const u32x4* kp = (const u32x4*)(p0 + (size_t)krow * NIN0 + 2304 + h * 64); float d = 0.f;
#pragma unroll
                for (int i = 0; i < 8; ++i) { const u32x4 x = kp[i];
#pragma unroll
                    for (int jx = 0; jx < 4; ++jx) d += q[i * 8 + 2 * jx] * bfu(x[jx], 0) + q[i * 8 + 2 * jx + 1] * bfu(x[jx], 1); }
                sc[jj] = d * 0.125f + bias; }
            mx = fmaxf(mx, sc[jj]); }
#pragma unroll
        for (int o = 1; o < 64; o <<= 1) mx = fmaxf(mx, __shfl_xor(mx, o));
        float sum = 0.f;
#pragma unroll
        for (int jj = 0; jj < 6; ++jj) { const int j = jj * 64 + lane; const float pv = j < nkeys ? __expf(sc[jj] - mx) : 0.f; sum += pv; if (j < 384) pbuf[w][j] = pv; }
        sum = wave_sum(sum);
        __builtin_amdgcn_s_waitcnt(0xc07f); asm volatile("" ::: "memory");
        float acc = 0.f;
        for (int j = 0; j < nkeys; ++j) { int krow;
            if (lat && j < 128) { const int kr = j >> 4, kc = j & 15; krow = b * TL + (r0 + kr) * 64 + c0 + kc; }
            else { const int l = lat ? j - 128 : j; krow = MLAT + b * LC + l; }
            acc += pbuf[w][j] * bf2f(p0[(size_t)krow * NIN0 + 2816 + h * 64 + lane]); }
        mix[(size_t)grow * DM + 512 + h * 64 + lane] = f2bf(acc / sum);
        __builtin_amdgcn_s_waitcnt(0xc07f); asm volatile("" ::: "memory");
    }
}

__device__ __forceinline__ void ph_hgrn_scan(const MP& p, int bid, int dir) {
    const bf16_t* p1 = (const bf16_t*)(p.ws + WS_BIG); const float* lbv = (const float*)(p.ws + WS_LB); bf16_t* obuf = (bf16_t*)(p.ws + WS_BUF0);
    const int b = bid >> 3, h = bid & 7; const int tid = threadIdx.x, v = tid >> 2, kq = tid & 3;
    float S[32], lb[32];
#pragma unroll
    for (int i = 0; i < 32; ++i) { S[i] = 0.f; lb[i] = lbv[h * 128 + kq * 32 + i]; }
    const int nsteps = LC + TL; const int fcol = (dir ? 2048 : 1024) + h * 128 + kq * 32, qcol = h * 128 + kq * 32, icol = 3072 + h * 128 + v;
    auto grow_of = [&](int s) -> size_t { if (s < LC) { const int t = dir ? LC - 1 - s : s; return (size_t)MLAT + b * LC + t; } const int s2 = s - LC; const int t = dir ? TL - 1 - s2 : s2; return (size_t)b * TL + t; };
    u32x4 fq_[4], qq_[4], nf_[4], nq_[4]; float iv, niv;
    { const size_t g0 = grow_of(0); const u32x4* fp = (const u32x4*)(p1 + g0 * NIN1 + fcol); const u32x4* qp = (const u32x4*)(p1 + g0 * NIN1 + qcol);
#pragma unroll
      for (int i = 0; i < 4; ++i) { fq_[i] = fp[i]; qq_[i] = qp[i]; nf_[i] = fp[i]; nq_[i] = qp[i]; } iv = bf2f(p1[g0 * NIN1 + icol]); niv = iv; }
    for (int s = 0; s < nsteps; ++s) {
        const size_t grow = grow_of(s);
        if (s + 1 < nsteps) { const size_t g1 = grow_of(s + 1); const u32x4* fp = (const u32x4*)(p1 + g1 * NIN1 + fcol); const u32x4* qp = (const u32x4*)(p1 + g1 * NIN1 + qcol);
#pragma unroll
            for (int i = 0; i < 4; ++i) { nf_[i] = fp[i]; nq_[i] = qp[i]; } niv = bf2f(p1[g1 * NIN1 + icol]); }
        float o = 0.f;
#pragma unroll
        for (int i = 0; i < 32; ++i) { const float f = bfu(fq_[i >> 3][(i >> 1) & 3], i & 1), qv = bfu(qq_[i >> 3][(i >> 1) & 3], i & 1);
            const float fg = lb[i] + (1.f - lb[i]) * sigmoidf_(f); S[i] = fg * S[i] + (1.f - fg) * iv; o += S[i] * qv; }
        o += __shfl_xor(o, 1); o += __shfl_xor(o, 2);
        if (kq == 0 && s >= LC) { bf16_t* op = obuf + grow * DM + h * 128 + v; *op = dir ? f2bf(o + bf2f(*op)) : f2bf(o); }
#pragma unroll
        for (int i = 0; i < 4; ++i) { fq_[i] = nf_[i]; qq_[i] = nq_[i]; } iv = niv;
    }
}
__device__ __forceinline__ void ph_hgrn_out(const MP& p, int bid, int nblk) {
    bf16_t* obuf = (bf16_t*)(p.ws + WS_BUF0); const bf16_t* p1 = (const bf16_t*)(p.ws + WS_BIG); const float* g = p.in[28];
    const int w = threadIdx.x >> 6, lane = threadIdx.x & 63;
    for (int row = bid * 8 + w; row < MLAT; row += nblk * 8) {
        bf16_t* op = obuf + (size_t)row * DM + lane * 16; const bf16_t* gp = p1 + (size_t)row * NIN1 + 4096 + lane * 16;
        float o[16]; float s = 0.f;
#pragma unroll
        for (int i = 0; i < 16; ++i) { o[i] = bf2f(op[i]); s += o[i] * o[i]; }
        s = wave_sum(s); const float rs = rsqrtf(s * (1.f / 1024.f) + NORM_EPS);
#pragma unroll
        for (int i = 0; i < 16; ++i) op[i] = f2bf(o[i] * rs * g[lane * 16 + i] * siluf_(bf2f(gp[i])));
    }
}

template <int ACT> __device__ __forceinline__ void ph_gemm_act(LAS unsigned char* lds, const bf16_t* A, const bf16_t* Bt, int M, int N, int K, bf16_t* O, const float* ssq, const float* shw, int G, int bid, bf16_t* vtl = nullptr, bf16_t* vtc = nullptr) {
    pg8::Gemm g; g.A = A; g.Bt = Bt; g.M = M; g.N = N; g.K = K; pg8::StaticOrder S; S.init(M, N, G, bid);
    pg8::EpiAct<ACT> E; E.O = O; E.ldc = N; E.ssq = ssq; E.shw = shw; E.ncol = N; E.vtl = vtl; E.vtc = vtc;
    pg8::gemm_phase<pg8::EpiAct<ACT>, pg8::StaticOrder, true, true>(lds, g, S, E);
}
template <bool HB> __device__ __forceinline__ void ph_gemm_res(LAS unsigned char* lds, const bf16_t* A, const bf16_t* Bt, int M, int K, const float* hin_lat, const float* hin_ctx, float* hout_lat, float* hout_ctx,
                                                              const float* gate, const float* gsn, bf16_t* hb, float* ssq, int G, int bid) {
    pg8::Gemm g; g.A = A; g.Bt = Bt; g.M = M; g.N = DM; g.K = K; pg8::StaticOrder S; S.init(M, DM, G, bid);
    pg8::EpiRes<HB> E; E.hin_lat = hin_lat; E.hin_ctx = hin_ctx; E.hout_lat = hout_lat; E.hout_ctx = hout_ctx; E.gate = gate; E.gsn = gsn; E.hb = hb; E.ssq = ssq;
    pg8::gemm_phase<pg8::EpiRes<HB>, pg8::StaticOrder, true, true>(lds, g, S, E);
}

constexpr int NPHASE = 20;
__global__ void __launch_bounds__(NTHREADS, 2) mega(MP p) {
    extern __shared__ __attribute__((aligned(16))) unsigned char lds_raw[];
    LAS unsigned char* lds = (LAS unsigned char*)lds_raw;
    char* ldsg = (char*)lds_raw;
    const int tid = threadIdx.x;
    const int G = gridDim.x, bid = blockIdx.x;
    volatile LAS unsigned* MISC = (volatile LAS unsigned*)(lds + MISC_OFF);
    for (int u = tid; u < (LDS_BYTES - LDSCTL_OFF) / 4; u += NTHREADS) ((LAS unsigned*)(lds + LDSCTL_OFF))[u] = 0u;
    __syncthreads();
    unsigned* ctl = (unsigned*)(p.ws + WS_CTL);
    const bool multi = (p.ph_hi - p.ph_lo) > 1;
    XcdBarrier bar; bar.bar = ctl + CW_BAR; bar.x = 0; bar.st = nullptr;
    if (multi) bar = xcd_barrier_post(ctl + CW_BAR, MISC + 8);
    const int lo = p.ph_lo, hi = p.ph_hi;
#define IN(k) (lo <= (k) && (k) < hi)
#define SEAM(k) do { if (IN(k) && IN((k) + 1)) xcd_barrier(bar); } while (0)
    char* ws = p.ws; float* out = p.out;
    const float* mod = (const float*)(ws + WS_MOD); const float* gs = (const float*)(ws + WS_GS); float* ssq = (float*)(ws + WS_SSQ); float* hctx = (float*)(ws + WS_HCTX);
    bf16_t* buf0 = (bf16_t*)(ws + WS_BUF0); bf16_t* big = (bf16_t*)(ws + WS_BIG); bf16_t* hbs = (bf16_t*)(ws + WS_BIG + BIG_HB);
    const float* mod1 = mod + (size_t)5 * 6144;
#define WTP(off) ((const bf16_t*)(ws + WS_WT + (off)))
    constexpr int NA_TASKS = MALL * 8, NA_HALF = NA_TASKS / 2;

    if (IN(0)) { ph_adaln(p, bid, G, ldsg); ph_wt(p, bid, G, ldsg); ph_lora_w(p, bid, G); } SEAM(0);
    if (IN(1)) { ph_gs(p, bid, G); ph_shw(p, bid, G, ldsg); ph_norm_in(p, bid, G); } SEAM(1);
    if (IN(2)) ph_gemm_act<3>(lds, buf0, WTP(WT_IN0), MALL, NIN0, DM, big, ssq, (const float*)(ws + WS_SHW0), G, bid, (bf16_t*)(ws + WS_VTL), (bf16_t*)(ws + WS_VTC)); SEAM(2);
    if (IN(3)) ph_rwkv<0>(p, bid, G, lds); SEAM(3);
    if (IN(4)) ph_rwkv_scan2(p, bid, G); SEAM(4);
    if (IN(5)) ph_rwkv<1>(p, bid, G, lds); SEAM(5);
    if (IN(6)) ph_na2(p, bid, G, lds); SEAM(6);
    SEAM(7); SEAM(8);
    if (IN(9)) ph_gemm_res<true>(lds, buf0, WTP(WT_OUT0), MALL, DM, p.in[0], p.in[2], out, hctx, mod + 2 * 1024, gs + 1 * 5 * 1024, hbs, ssq, G, bid); SEAM(9);
    if (IN(10)) ph_gemm_act<1>(lds, hbs, WTP(WT_W10), MALL, NHID, DM, big, ssq, (const float*)(ws + WS_SHW1), G, bid); SEAM(10);
    if (IN(11)) ph_gemm_res<true>(lds, big, WTP(WT_W20), MALL, NHID, out, hctx, out, hctx, mod + 5 * 1024, gs + 2 * 5 * 1024, buf0, ssq, G, bid); SEAM(11);
    if (IN(12)) ph_gemm_act<2>(lds, buf0, WTP(WT_IN1), MALL, NIN1, DM, big, ssq, (const float*)(ws + WS_SHW2), G, bid); SEAM(12);
    if (IN(13)) ph_hgrn<false>(p, bid, G, lds); SEAM(13);
    if (IN(14)) ph_hgrn<true>(p, bid, G, lds); SEAM(14);
    if (IN(15)) ph_hgrn_out2(p, bid, G); SEAM(15);
    if (IN(16)) ph_gemm_res<true>(lds, buf0, WTP(WT_OUT1), MLAT, DM, out, hctx, out, hctx, mod1 + 2 * 1024, gs + 3 * 5 * 1024, hbs, ssq, G, bid); SEAM(16);
    if (IN(17)) ph_gemm_act<1>(lds, hbs, WTP(WT_W11), MLAT, NHID, DM, big, ssq, (const float*)(ws + WS_SHW3), G, bid); SEAM(17);
    if (IN(18)) ph_gemm_res<false>(lds, big, WTP(WT_W21), MLAT, NHID, out, hctx, out, hctx, mod1 + 5 * 1024, nullptr, nullptr, ssq, G, bid); SEAM(18);
    if (IN(19)) ph_final(p, bid, G);
#undef IN
#undef SEAM
#undef WTP
}

#ifndef MK_N_LAUNCHES
#define MK_N_LAUNCHES 1
#endif
extern "C" void kernel_launch(void* const* d_in, const int* in_sizes, int n_in, void* d_out, int out_size, void* d_ws, size_t ws_size, hipStream_t stream) {
    static int grid = 0;
    if (grid == 0) {
        if (n_in != 30 || ws_size < WS_END) { fprintf(stderr, "kernel_launch: bad inputs (n_in %d, ws %zu < %zu)\n", n_in, ws_size, (size_t)WS_END); grid = -1; return; }
        int dev = 0, cus = 0, per_cu = 0;
        if (hipGetDevice(&dev) != hipSuccess || hipDeviceGetAttribute(&cus, hipDeviceAttributeMultiprocessorCount, dev) != hipSuccess) { grid = -1; return; }
        if (hipFuncSetAttribute((const void*)mega, hipFuncAttributeMaxDynamicSharedMemorySize, LDS_BYTES) != hipSuccess) { fprintf(stderr, "kernel_launch: hipFuncSetAttribute failed\n"); grid = -1; return; }
        if (hipOccupancyMaxActiveBlocksPerMultiprocessor(&per_cu, (const void*)mega, NTHREADS, LDS_BYTES) != hipSuccess || per_cu < 1) { fprintf(stderr, "kernel_launch: occupancy query says %d\n", per_cu); per_cu = 1; }
        (void)hipGetLastError();
        grid = cus;
    }
    if (grid < 0) return;
    (void)hipMemsetAsync((char*)d_ws + WS_CTL, 0, CTL_ZERO_BYTES, stream);
    MP a; memset((void*)&a, 0, sizeof(a));
    for (int i = 0; i < 30; ++i) a.in[i] = (const float*)d_in[i];
    a.out = (float*)d_out; a.ws = (char*)d_ws;
#if MK_N_LAUNCHES == 1
    a.ph_lo = 0; a.ph_hi = NPHASE;
    hipLaunchKernelGGL(mega, dim3(grid), dim3(NTHREADS), LDS_BYTES, stream, a);
#else
    for (int ph = 0; ph < NPHASE; ++ph) { a.ph_lo = ph; a.ph_hi = ph + 1; hipLaunchKernelGGL(mega, dim3(grid), dim3(NTHREADS), LDS_BYTES, stream, a); }
#endif
}
```

```cpp
#include <hip/hip_runtime.h>
#include <cstdio>
#include <cstdint>
#include <cstring>
namespace pg8 {
#define PG8_LAS __attribute__((address_space(3)))
typedef unsigned short bf16_t;
typedef short bf16x8 __attribute__((ext_vector_type(8)));
typedef float f32x4 __attribute__((ext_vector_type(4)));
typedef unsigned u32x4 __attribute__((ext_vector_type(4)));
constexpr int BM = 256, BK = 64, HALF = 128, HTB = HALF * BK * 2  , STAGE_BYTES = 8 * HTB, NXCD = 8, WGM = 8;

__host__ __device__ __forceinline__ int lds_byte(int r, int c) { const int st = (r >> 4) * 2 + (c >> 5), rr = r & 15, cc = c & 31, ob = rr * 64 + cc * 2; return st * 1024 + (ob ^ (((ob >> 9) & 1) << 5)); }
__host__ __device__ __forceinline__ void stage_rc(int b, int& R, int& C) { const int st = b / 1024, sb = b % 1024, swz = sb ^ (((sb >> 9) & 1) << 5); R = (st >> 1) * 16 + swz / 64; C = (st & 1) * 32 + (swz % 64) / 2; }
__host__ __device__ __forceinline__ int perm32(int rho) { const int n = rho >> 4, i = rho & 15; return 8 * (i >> 2) + 4 * n + (i & 3); }

struct Unit { int pm, pn; };
struct Gemm { const bf16_t* A; const bf16_t* Bt; int M, N, K; };

struct StaticOrder {
    int nM, nN, nwg, G, c;
    __host__ __device__ void init(int M, int N, int G_, int c_) { nM = M / BM; nN = N / BM; nwg = nM * nN; G = G_; c = c_; }
    __host__ __device__ bool next(int i, Unit& u) const {
        const long L = (long)i * G + c; if (L >= nwg) return false;
        int wgid = (int)L; { const int q = nwg / NXCD, r = nwg % NXCD, xcd = wgid % NXCD, off = wgid / NXCD; wgid = (xcd < r ? xcd * (q + 1) : r * (q + 1) + (xcd - r) * q) + off; }
        const int nig = WGM * nN, gid = wgid / nig, fm = gid * WGM, gsz = (nM - fm) < WGM ? (nM - fm) : WGM;
        u.pm = fm + ((wgid % nig) % gsz); u.pn = (wgid % nig) / gsz; return true;
    }
    __device__ __forceinline__ void a_ready(const Unit&) const {}
    __device__ __forceinline__ void done(const Unit&) const {}
};
typedef float f32x2_t __attribute__((ext_vector_type(2))); typedef __bf16 bf16x2_t __attribute__((ext_vector_type(2)));
__device__ __forceinline__ unsigned cvt_pk_bf16(float lo, float hi) { f32x2_t v = {lo, hi}; bf16x2_t b = __builtin_convertvector(v, bf16x2_t); return __builtin_bit_cast(unsigned, b); }
template <class Epi, class Sched, bool ALIGN_EPI = false, bool SP2 = false>
__device__ __forceinline__ void gemm_phase(PG8_LAS unsigned char* lds, const Gemm g, const Sched& S, const Epi& E) {
    const int tid = threadIdx.x, wid = __builtin_amdgcn_readfirstlane(tid >> 6), lane = tid & 63, wr = wid >> 2, wc = wid & 3, fr = lane & 15, fq = lane >> 4;
    const int K = g.K, nt = K / BK;
    unsigned voffA[2], voffB[2];
#pragma unroll
    for (int i = 0; i < 2; ++i) { int R, C; stage_rc(tid * 16 + i * 8192, R, C); const int Rb = Epi::PERM ? ((R & ~31) + perm32(R & 31)) : R;
        voffA[i] = (unsigned)(R * K + C) * 2u; voffB[i] = (unsigned)(Rb * K + C) * 2u; }
    const size_t kstep = (size_t)(BK * 2);
    const size_t hstep = (size_t)HALF * K * 2;
    const size_t tstep = 2 * hstep;
    const unsigned ldsw = (unsigned)wid * 1024u;
    const int aoff = lds_byte(wr * 64 + fr, fq * 8), boff = lds_byte(wc * 32 + fr, fq * 8);
#define PG8_SA(b, h) (((b) * 2 + (h)) * HTB)
#define PG8_SB(b, h) ((4 + (b) * 2 + (h)) * HTB)
#define PG8_STAGE(bufoff, gbase, voff) do { _Pragma("unroll") for (int _i = 0; _i < 2; ++_i) \
        __builtin_amdgcn_global_load_lds((const unsigned*)((const char*)(gbase) + (voff)[_i]), (PG8_LAS unsigned*)(lds + (bufoff) + ldsw + _i * 8192), 16, 0, 0); } while (0)
#define PG8_LDA(dst, b, h) do { _Pragma("unroll") for (int m = 0; m < 4; ++m) _Pragma("unroll") for (int k = 0; k < 2; ++k) dst[m][k] = *(const PG8_LAS bf16x8*)(lds + PG8_SA(b, h) + aoff + m * 2048 + k * 1024); } while (0)
#define PG8_LDB(dst, b, h) do { _Pragma("unroll") for (int n = 0; n < 2; ++n) _Pragma("unroll") for (int k = 0; k < 2; ++k) dst[n][k] = *(const PG8_LAS bf16x8*)(lds + PG8_SB(b, h) + boff + n * 2048 + k * 1024); } while (0)
#define PG8_MMA(ai, bj, At, Bt) do { __builtin_amdgcn_s_setprio(1); _Pragma("unroll") for (int m = 0; m < 4; ++m) _Pragma("unroll") for (int n = 0; n < 2; ++n) _Pragma("unroll") for (int k = 0; k < 2; ++k) \
        acc[ai][bj][m][n] = __builtin_amdgcn_mfma_f32_16x16x32_bf16(Bt[n][k], At[m][k], acc[ai][bj][m][n], 0, 0, 0); __builtin_amdgcn_s_setprio(0); } while (0)
#define PG8_WAIT_V(n) asm volatile("s_waitcnt vmcnt(" #n ")" ::: "memory")
#define PG8_WAIT_L(n) asm volatile("s_waitcnt lgkmcnt(" #n ")" ::: "memory")
#define PG8_BAR __builtin_amdgcn_s_barrier()
#define PG8_SCHED __builtin_amdgcn_sched_barrier(0)
    Unit cur, nxt; int ui = 0;
    if (!S.next(0, cur)) return;
    f32x4 acc[2][2][4][2];
#pragma unroll
    for (int a = 0; a < 2; ++a)
#pragma unroll
        for (int b = 0; b < 2; ++b)
#pragma unroll
            for (int m = 0; m < 4; ++m)
#pragma unroll
                for (int n = 0; n < 2; ++n) acc[a][b][m][n] = (f32x4){0.f, 0.f, 0.f, 0.f};
    bf16x8 At[4][2], B0[2][2], B1[2][2];
    const char* cA = (const char*)g.A + (size_t)cur.pm * tstep; const char* cB = (const char*)g.Bt + (size_t)cur.pn * tstep;
    S.a_ready(cur);
    if constexpr (SP2) {
        PG8_STAGE(PG8_SB(0, 0), cB, voffB); PG8_STAGE(PG8_SB(0, 1), cB + hstep, voffB); PG8_STAGE(PG8_SA(0, 0), cA, voffA); PG8_STAGE(PG8_SA(0, 1), cA + hstep, voffA);
        if (wr == 1) PG8_BAR;
        PG8_WAIT_V(2); PG8_BAR;
        PG8_STAGE(PG8_SB(1, 0), cB + kstep, voffB); PG8_STAGE(PG8_SA(1, 0), cA + kstep, voffA); PG8_STAGE(PG8_SB(1, 1), cB + hstep + kstep, voffB);
        PG8_WAIT_V(6); PG8_BAR;
    } else {
        PG8_STAGE(PG8_SB(0, 0), cB, voffB); PG8_STAGE(PG8_SA(0, 0), cA, voffA); PG8_STAGE(PG8_SB(0, 1), cB + hstep, voffB); PG8_STAGE(PG8_SA(0, 1), cA + hstep, voffA);
        if (wr == 1) PG8_BAR;
        PG8_WAIT_V(4); PG8_BAR;
        PG8_STAGE(PG8_SB(1, 0), cB + kstep, voffB); PG8_STAGE(PG8_SA(1, 0), cA + kstep, voffA); PG8_STAGE(PG8_SB(1, 1), cB + hstep + kstep, voffB);
        PG8_WAIT_V(6); PG8_BAR;
    }
    for (;;) {
        const bool has_next = S.next(ui + 1, nxt);
        const char* nA = has_next ? (const char*)g.A + (size_t)nxt.pm * tstep : cA; const char* nB = has_next ? (const char*)g.Bt + (size_t)nxt.pn * tstep : cB;
        for (int t = 0; t < nt; t += 2) {
            const bool last = (t == nt - 2);
            const char* a1 = cA + (size_t)(t + 1) * kstep;
            const char* a2 = last ? nA : cA + (size_t)(t + 2) * kstep; const char* b2 = last ? nB : cB + (size_t)(t + 2) * kstep;
            const char* a3 = a2 + kstep; const char* b3 = b2 + kstep;
            if (last && has_next) S.a_ready(nxt);
            if constexpr (SP2) {
            PG8_LDB(B0, 0, 0); PG8_LDB(B1, 0, 1); PG8_SCHED; PG8_LDA(At, 0, 0); PG8_STAGE(PG8_SA(1, 1), a1 + hstep, voffA);
            PG8_WAIT_V(8); PG8_WAIT_L(0); PG8_BAR; PG8_MMA(0, 0, At, B0); PG8_MMA(0, 1, At, B1); PG8_BAR; PG8_SCHED;
            PG8_LDA(At, 0, 1); PG8_STAGE(PG8_SB(0, 0), b2, voffB); PG8_STAGE(PG8_SB(0, 1), b2 + hstep, voffB); PG8_STAGE(PG8_SA(0, 0), a2, voffA);
            PG8_WAIT_V(8); PG8_WAIT_L(0); PG8_BAR; PG8_MMA(1, 0, At, B0); PG8_MMA(1, 1, At, B1); PG8_BAR; PG8_SCHED;
            PG8_LDB(B0, 1, 0); PG8_LDB(B1, 1, 1); PG8_SCHED; PG8_LDA(At, 1, 0); PG8_STAGE(PG8_SA(0, 1), a2 + hstep, voffA);
            PG8_WAIT_V(8); PG8_WAIT_L(0); PG8_BAR; PG8_MMA(0, 0, At, B0); PG8_MMA(0, 1, At, B1); PG8_BAR; PG8_SCHED;
            PG8_LDA(At, 1, 1); PG8_STAGE(PG8_SB(1, 0), b3, voffB); PG8_STAGE(PG8_SB(1, 1), b3 + hstep, voffB); PG8_STAGE(PG8_SA(1, 0), a3, voffA);
            PG8_WAIT_V(8); PG8_WAIT_L(0); PG8_BAR; PG8_MMA(1, 0, At, B0); PG8_MMA(1, 1, At, B1); PG8_BAR; PG8_SCHED;
            } else {
            PG8_LDB(B0, 0, 0); PG8_SCHED; PG8_LDA(At, 0, 0); PG8_STAGE(PG8_SA(1, 1), a1 + hstep, voffA);
            PG8_WAIT_L(8); PG8_BAR; PG8_WAIT_L(0); PG8_MMA(0, 0, At, B0); PG8_BAR; PG8_SCHED;
            PG8_LDB(B1, 0, 1); PG8_STAGE(PG8_SB(0, 0), b2, voffB);
            PG8_BAR; PG8_WAIT_L(0); PG8_MMA(0, 1, At, B1); PG8_BAR;
            PG8_LDA(At, 0, 1); PG8_STAGE(PG8_SA(0, 0), a2, voffA);
            PG8_BAR; PG8_WAIT_L(0); PG8_MMA(1, 0, At, B0); PG8_BAR; PG8_SCHED;
            PG8_STAGE(PG8_SB(0, 1), b2 + hstep, voffB);
            PG8_WAIT_V(6); PG8_BAR; PG8_MMA(1, 1, At, B1); PG8_BAR;
            PG8_LDB(B0, 1, 0); PG8_SCHED; PG8_LDA(At, 1, 0); PG8_STAGE(PG8_SA(0, 1), a2 + hstep, voffA);
            PG8_WAIT_L(8); PG8_BAR; PG8_WAIT_L(0); PG8_MMA(0, 0, At, B0); PG8_BAR; PG8_SCHED;
            PG8_LDB(B1, 1, 1); PG8_STAGE(PG8_SB(1, 0), b3, voffB);
            PG8_BAR; PG8_WAIT_L(0); PG8_MMA(0, 1, At, B1); PG8_BAR;
            PG8_LDA(At, 1, 1); PG8_STAGE(PG8_SA(1, 0), a3, voffA);
            PG8_BAR; PG8_WAIT_L(0); PG8_MMA(1, 0, At, B0); PG8_BAR; PG8_SCHED;
            PG8_STAGE(PG8_SB(1, 1), b3 + hstep, voffB);
            PG8_WAIT_V(6); PG8_BAR; PG8_MMA(1, 1, At, B1); PG8_BAR;
            }
        }
        if constexpr (ALIGN_EPI) { if (wr == 0) PG8_BAR; }
        if constexpr (!Epi::AFTER_DRAIN) { E(acc, cur, wr, wc, fr, fq); S.done(cur); }
        if (!has_next) break;
#pragma unroll
        for (int a = 0; a < 2; ++a)
#pragma unroll
            for (int b = 0; b < 2; ++b)
#pragma unroll
                for (int m = 0; m < 4; ++m)
#pragma unroll
                    for (int n = 0; n < 2; ++n) acc[a][b][m][n] = (f32x4){0.f, 0.f, 0.f, 0.f};
        cur = nxt; cA = nA; cB = nB; ++ui;
        if constexpr (ALIGN_EPI) { if (wr == 1) PG8_BAR; }
    }
    PG8_WAIT_V(0);
    if constexpr (!ALIGN_EPI) { if (wr == 0) PG8_BAR; }
    PG8_BAR;
    if constexpr (Epi::AFTER_DRAIN) { E.fused(acc, cur, wr, wc, fr, fq, lds, wid, lane); S.done(cur); }
#undef PG8_SA
#undef PG8_SB
#undef PG8_STAGE
#undef PG8_LDA
#undef PG8_LDB
#undef PG8_MMA
#undef PG8_WAIT_V
#undef PG8_WAIT_L
#undef PG8_BAR
#undef PG8_SCHED
}
}

typedef unsigned short bf16_t;
typedef float f32x4 __attribute__((ext_vector_type(4)));
typedef unsigned u32x4 __attribute__((ext_vector_type(4)));
typedef unsigned u32x2 __attribute__((ext_vector_type(2)));
constexpr int DM = 1024, NB = 4, TL = 8192, LC = 256;
constexpr int MLAT = NB * TL, MCTX = NB * LC, MALL = MLAT + MCTX;
constexpr int NIN0 = 3328, NIN1 = 5120, NHID = 4096;
constexpr float NORM_EPS = 1e-6f;

__device__ __forceinline__ float bf2f(bf16_t b) { return __uint_as_float(((unsigned)b) << 16); }
__device__ __forceinline__ bf16_t f2bf(float f) { return (bf16_t)pg8::cvt_pk_bf16(f, f); }
__device__ __forceinline__ unsigned pk2(float lo, float hi) { return pg8::cvt_pk_bf16(lo, hi); }
__device__ __forceinline__ float frcp(float x) { return __builtin_amdgcn_rcpf(x); }
__device__ __forceinline__ float sigmoidf_(float x) { return frcp(1.f + __expf(-x)); }
__device__ __forceinline__ float siluf_(float x) { return x * frcp(1.f + __expf(-x)); }
__device__ __forceinline__ float wave_sum(float v) {
#pragma unroll
    for (int o = 1; o < 64; o <<= 1) v += __shfl_xor(v, o);
    return v;
}

constexpr size_t WS_CTL  = 0;
constexpr size_t WS_MOD  = 65536;
constexpr size_t WS_LB   = WS_MOD + 2 * 5 * 6144 * 4;
constexpr size_t WS_GS   = WS_LB + 4096;
constexpr size_t WS_SHW0 = WS_GS + 4 * 5 * 1024 * 4;
constexpr size_t WS_SHW1 = WS_SHW0 + 5 * 3328 * 4;
constexpr size_t WS_SHW2 = WS_SHW1 + 5 * 4096 * 4;
constexpr size_t WS_SHW3 = WS_SHW2 + 5 * 5120 * 4;
constexpr size_t WS_SSQ  = WS_SHW3 + 5 * 4096 * 4;
constexpr size_t WS_BC   = WS_SSQ + (size_t)MALL * 64;
constexpr size_t WS_LORAW = WS_BC + (size_t)MALL * 32;
constexpr size_t WS_HCTX = WS_LORAW + (size_t)196608 * 2;
constexpr size_t WS_WT   = WS_HCTX + (size_t)MCTX * DM * 4;
constexpr size_t WT_IN1 = 0, WT_OUT1 = WT_IN1 + (size_t)NIN1 * DM * 2, WT_W11 = WT_OUT1 + (size_t)DM * DM * 2, WT_W21 = WT_W11 + (size_t)NHID * DM * 2, WT_L1END = WT_W21 + (size_t)NHID * DM * 2;
constexpr size_t WS_BUF0 = WS_WT + WT_L1END;
constexpr size_t WS_BIG  = WS_BUF0 + (size_t)MALL * DM * 2;
constexpr size_t BIG_HB  = (size_t)MALL * NHID * 2;
constexpr size_t BIG_P0END = (size_t)MALL * NIN0 * 2;
constexpr size_t WS_WTL0 = WS_BIG + (size_t)MALL * NIN1 * 2;
constexpr size_t WT_IN0 = WS_WTL0 - WS_WT, WT_OUT0 = WT_IN0 + (size_t)NIN0 * DM * 2, WT_W10 = WT_OUT0 + (size_t)DM * DM * 2, WT_W20 = WT_W10 + (size_t)NHID * DM * 2, WT_L0END = WT_W20 + (size_t)NHID * DM * 2;
constexpr size_t WS_O1   = WS_WTL0;
constexpr size_t WS_SLOC = WS_O1 + (size_t)MLAT * DM * 2;
constexpr size_t WS_DSEG = WS_SLOC + (size_t)64 * 3 * 128 * 128 * 4;
constexpr size_t WS_END  = WS_DSEG + (size_t)64 * 3 * 128 * 4;
static_assert(WS_WT + WT_L0END <= WS_SLOC, "layout");
static_assert(WS_END <= (size_t)512 * 1024 * 1024, "workspace must fit 512 MiB");

__device__ __forceinline__ void gemv5_item(const float* W, int ldw, int n0, const float* s, float* red, float* out, int ldo, const float* bias) {
    const int tid = threadIdx.x, w = tid >> 6, lane = tid & 63;
    float a0 = 0.f, a1 = 0.f, a2 = 0.f, a3 = 0.f, a4 = 0.f;
    const float* wp = W + (size_t)(w * 128) * ldw + n0 + lane;
#pragma unroll 8
    for (int k = 0; k < 128; ++k) { const float wv = wp[(size_t)k * ldw]; const int kk = w * 128 + k;
        a0 += s[kk] * wv; a1 += s[1024 + kk] * wv; a2 += s[2048 + kk] * wv; a3 += s[3072 + kk] * wv; a4 += s[4096 + kk] * wv; }
    red[(w * 5 + 0) * 64 + lane] = a0; red[(w * 5 + 1) * 64 + lane] = a1; red[(w * 5 + 2) * 64 + lane] = a2; red[(w * 5 + 3) * 64 + lane] = a3; red[(w * 5 + 4) * 64 + lane] = a4;
    __syncthreads();
    if (tid < 320) { const int mb = tid >> 6; float r = bias ? bias[n0 + lane] : 0.f;
#pragma unroll
        for (int ww = 0; ww < 8; ++ww) r += red[(ww * 5 + mb) * 64 + lane];
        out[(size_t)mb * ldo + n0 + lane] = r; }
    __syncthreads();
}

__device__ __forceinline__ void transpose_item(const float* W, int K, int N, bf16_t* WT, float* scr, int item, int lane) {
    const int nblk = N / 32, kb = item / nblk, nb = item % nblk, k0 = 64 * kb, n0 = 32 * nb;
#pragma unroll 8
    for (int i = 0; i < 32; ++i) { const int kk = 2 * i + (lane >> 5); scr[kk * 33 + (lane & 31)] = W[(size_t)(k0 + kk) * N + n0 + (lane & 31)]; }
    __builtin_amdgcn_s_waitcnt(0xc07f); asm volatile("" ::: "memory");
    const int c = lane & 7;
#pragma unroll
    for (int j = 0; j < 4; ++j) { const int n = (lane >> 3) + 8 * j; const float* sp = scr + (8 * c) * 33 + n;
        u32x4 o; o.x = pk2(sp[0 * 33], sp[1 * 33]); o.y = pk2(sp[2 * 33], sp[3 * 33]); o.z = pk2(sp[4 * 33], sp[5 * 33]); o.w = pk2(sp[6 * 33], sp[7 * 33]);
        *(u32x4*)(WT + (size_t)(n0 + n) * K + k0 + 8 * c) = o; }
    __builtin_amdgcn_s_waitcnt(0xc07f); asm volatile("" ::: "memory");
}
namespace pg8 {
__device__ __forceinline__ float row_rstd(const float* ssq, int row) {
    const f32x4* p = (const f32x4*)(ssq + (size_t)row * 16); const f32x4 a = p[0], b = p[1], c = p[2], d = p[3];
    const float s = ((a.x + a.y) + (a.z + a.w)) + ((b.x + b.y) + (b.z + b.w)) + ((c.x + c.y) + (c.z + c.w)) + ((d.x + d.y) + (d.z + d.w));
    return rsqrtf(s * (1.f / 1024.f) + NORM_EPS);
}
template <int ACT> struct EpiAct {
    static constexpr bool PERM = true, AFTER_DRAIN = false;
    bf16_t* O; int ldc; const float* ssq; const float* shw; int ncol; bf16_t* vtl; bf16_t* vtc;
    __device__ __forceinline__ void operator()(const f32x4 (&acc)[2][2][4][2], const Unit& u, int wr, int wc, int fr, int fq) const {
        const int row0 = u.pm * BM + wr * 64 + fr, mb = u.pm < 128 ? (u.pm >> 5) : 4;
        const int col0 = u.pn * BM + wc * 32 + 8 * fq;
        f32x4 bv[2][2];
#pragma unroll
        for (int bj = 0; bj < 2; ++bj)
#pragma unroll
            for (int n = 0; n < 2; ++n) bv[bj][n] = *(const f32x4*)(shw + (size_t)mb * ncol + col0 + bj * HALF + 4 * n);
        const bool do_silu = (ACT == 2) && (u.pn < 4);
#pragma unroll
        for (int ai = 0; ai < 2; ++ai)
#pragma unroll
            for (int m = 0; m < 4; ++m) { const int row = row0 + ai * HALF + m * 16; const float rs = row_rstd(ssq, row);
                bf16_t* rowp = O + (size_t)row * ldc + col0;
#pragma unroll
                for (int bj = 0; bj < 2; ++bj) { f32x4 v0 = acc[ai][bj][m][0] * rs + bv[bj][0], v1 = acc[ai][bj][m][1] * rs + bv[bj][1];
                    if (ACT == 1) {
#pragma unroll
                        for (int j = 0; j < 4; ++j) { const float a = fmaxf(v0[j], 0.f), b = fmaxf(v1[j], 0.f); v0[j] = a * a; v1[j] = b * b; } }
                    if (ACT == 2) { if (do_silu) {
#pragma unroll
                        for (int j = 0; j < 4; ++j) { v0[j] = siluf_(v0[j]); v1[j] = siluf_(v1[j]); } } }
                    u32x4 w; w.x = cvt_pk_bf16(v0[0], v0[1]); w.y = cvt_pk_bf16(v0[2], v0[3]); w.z = cvt_pk_bf16(v1[0], v1[1]); w.w = cvt_pk_bf16(v1[2], v1[3]);
                    *(u32x4*)(rowp + bj * HALF) = w;
                    if (ACT == 3) { if (u.pn >= 11) { const int cv = col0 + bj * HALF - 2816, hh = cv >> 6, d0 = cv & 63;
                        const bool lat = u.pm < 128; const int bb = lat ? (row >> 13) : ((row - MLAT) >> 8), tt = lat ? (row & 8191) : ((row - MLAT) & 255);
                        bf16_t* vp = lat ? vtl + ((size_t)(bb * 8 + hh) * 64 + d0) * TL + tt : vtc + ((size_t)(bb * 8 + hh) * 64 + d0) * LC + tt; const size_t ld = lat ? TL : LC;
#pragma unroll
                        for (int jj = 0; jj < 4; ++jj) { vp[(size_t)(2 * jj) * ld] = (bf16_t)(w[jj] & 0xffffu); vp[(size_t)(2 * jj + 1) * ld] = (bf16_t)(w[jj] >> 16); } } } } }
    }
};
template <bool HB> struct EpiRes {
    static constexpr bool PERM = false, AFTER_DRAIN = false;
    const float* hin_lat; const float* hin_ctx; float* hout_lat; float* hout_ctx; const float* gate; const float* gsn; bf16_t* hb; float* ssq;
    __device__ __forceinline__ void operator()(const f32x4 (&acc)[2][2][4][2], const Unit& u, int wr, int wc, int fr, int fq) const {
        const bool lat = u.pm < 128; const int mb = lat ? (u.pm >> 5) : 4;
        const int row0 = u.pm * BM + wr * 64 + fr, col0 = u.pn * BM + wc * 32 + 4 * fq;
        const float* hin = lat ? hin_lat : hin_ctx - (size_t)MLAT * DM; float* hout = lat ? hout_lat : hout_ctx - (size_t)MLAT * DM;
        f32x4 gv[2][2], gn[2][2];
#pragma unroll
        for (int bj = 0; bj < 2; ++bj)
#pragma unroll
            for (int n = 0; n < 2; ++n) { gv[bj][n] = *(const f32x4*)(gate + (size_t)mb * 6144 + col0 + bj * HALF + n * 16);
                if (HB) gn[bj][n] = *(const f32x4*)(gsn + (size_t)mb * 1024 + col0 + bj * HALF + n * 16); }
#pragma unroll
        for (int ai = 0; ai < 2; ++ai)
#pragma unroll
            for (int m = 0; m < 4; ++m) { const int row = row0 + ai * HALF + m * 16; const size_t off = (size_t)row * DM + col0; float s = 0.f;
#pragma unroll
                for (int bj = 0; bj < 2; ++bj)
#pragma unroll
                    for (int n = 0; n < 2; ++n) { const f32x4 hi = *(const f32x4*)(hin + off + bj * HALF + n * 16); const f32x4 ho = hi + gv[bj][n] * acc[ai][bj][m][n];
                        *(f32x4*)(hout + off + bj * HALF + n * 16) = ho; s += (ho.x * ho.x + ho.y * ho.y) + (ho.z * ho.z + ho.w * ho.w);
                        if (HB) { const f32x4 hn = ho * gn[bj][n]; u32x2 w; w.x = cvt_pk_bf16(hn.x, hn.y); w.y = cvt_pk_bf16(hn.z, hn.w); *(u32x2*)(hb + off + bj * HALF + n * 16) = w; } }
                s += __shfl_xor(s, 16); s += __shfl_xor(s, 32);
                if (fq == 0) ssq[(size_t)row * 16 + u.pn * 4 + wc] = s;
                asm volatile("" ::: "memory"); }
    }
};
}

struct RwkvW { const float *mu_prev, *mu_next, *w0, *w_up, *a0, *a_up, *g_up, *k_k, *k_a, *r_k, *ln_g, *ln_b; };
struct RwkvTmp { bf16_t *r, *k, *v, *kk, *a0, *a1, *g; float *lw0, *lw1, *osum; };
__device__ __forceinline__ void lrow_info(int lr, int b0, int nbh, int& grow, int& t, int& slen) {
    if (lr < nbh * TL) { const int b = b0 + lr / TL; t = lr % TL; grow = b * TL + t; slen = TL; }
    else { const int l2 = lr - nbh * TL; const int b = b0 + l2 / LC; t = l2 % LC; grow = MLAT + b * LC + t; slen = LC; }
}
__device__ __forceinline__ float shifted(const bf16_t* p0, int grow, int t, int slen, int col, float mup, float mun) {
    const float x = bf2f(p0[(size_t)grow * NIN0 + col]);
    const float xp = t > 0 ? bf2f(p0[(size_t)(grow - 1) * NIN0 + col]) : 0.f;
    const float xn = t < slen - 1 ? bf2f(p0[(size_t)(grow + 1) * NIN0 + col]) : 0.f;
    return x + (xp - x) * mup + (xn - x) * mun;
}
struct ScanIn { u32x4 r[2], k[2], kk[2], a[2]; f32x4 lw[4]; float v; };
__device__ __forceinline__ void scan_load(ScanIn& I, const RwkvTmp& T, int dir, size_t lrow, int h, int v, int kq) {
    const size_t o = lrow * 512 + h * 64 + kq * 16;
    const u32x4* pr = (const u32x4*)(T.r + o); const u32x4* pk = (const u32x4*)(T.k + o); const u32x4* pkk = (const u32x4*)(T.kk + o); const u32x4* pa = (const u32x4*)((dir ? T.a1 : T.a0) + o);
    const f32x4* pl = (const f32x4*)((dir ? T.lw1 : T.lw0) + o);
    I.r[0] = pr[0]; I.r[1] = pr[1]; I.k[0] = pk[0]; I.k[1] = pk[1]; I.kk[0] = pkk[0]; I.kk[1] = pkk[1]; I.a[0] = pa[0]; I.a[1] = pa[1];
    I.lw[0] = pl[0]; I.lw[1] = pl[1]; I.lw[2] = pl[2]; I.lw[3] = pl[3];
    I.v = bf2f(T.v[lrow * 512 + h * 64 + v]);
}
__device__ __forceinline__ float bfu(unsigned w, int hi) { return __uint_as_float(hi ? (w & 0xffff0000u) : (w << 16)); }
#define LAS __attribute__((address_space(3)))
#define GAS __attribute__((address_space(1)))
constexpr int NWAVES = 8, NTHREADS = 512;
constexpr int RING_BYTES = 131072, LDS_BYTES = 147456, LDSCTL_OFF = LDS_BYTES - 1024, MISC_OFF = LDSCTL_OFF + 320;
constexpr int CW_BAR = 4096;
constexpr size_t CTL_ZERO_BYTES = 65536;

struct MP { const float* in[30]; float* out; char* ws; int ph_lo, ph_hi; };
#define XB_TMO      128
#define XB_XCNT(j)  (256  + 64 * (j))
#define XB_XSUB(j)  (1280 + 64 * (j))
#define XB_XGEN(j)  (2304 + 64 * (j))
#define XB_TOP      3328
#define XB_TOPGEN   3392
#define XCD_BAR_WORDS 3456
#define XB_SPIN_CAP (1u << 18)

__device__ __forceinline__ unsigned xb_ld(unsigned* p)              { return __hip_atomic_load(p, __ATOMIC_RELAXED, __HIP_MEMORY_SCOPE_AGENT); }
__device__ __forceinline__ unsigned xb_add(unsigned* p, unsigned v) { return __hip_atomic_fetch_add(p, v, __ATOMIC_RELAXED, __HIP_MEMORY_SCOPE_AGENT); }
__device__ __forceinline__ unsigned xb_xcc_id() { return (unsigned)__builtin_amdgcn_s_getreg((3 << 11) | 20) & 0xFu; }
#define XB_SPIN(cond, bar) do { unsigned _sp = 0; while (cond) { __builtin_amdgcn_s_sleep(1); \
    if ((++_sp & 255u) == 0u) { if (xb_ld(&(bar)[XB_TMO])) break; if (_sp > XB_SPIN_CAP) { atomicAdd(&(bar)[XB_TMO], 1u); break; } } } } while (0)

struct XcdBarrier {
    unsigned* bar; unsigned x;
    volatile LAS unsigned* st;
};

__device__ __forceinline__ XcdBarrier xcd_barrier_post(unsigned* bar, volatile LAS unsigned* st) {
    XcdBarrier b; b.bar = bar; b.x = xb_xcc_id(); b.st = st;
    if (threadIdx.x == 0) (void)xb_add(&bar[XB_XCNT(b.x)], 1u);
    return b;
}
__device__ __forceinline__ void xcd_barrier_complete(unsigned* bar, unsigned x, unsigned& nloc, unsigned& nx) {
    const unsigned G = gridDim.x * gridDim.y * gridDim.z;
    unsigned sum, cnt, mine, sp = 0u;
    for (;;) {
        sum = 0u; cnt = 0u; mine = 0u;
#pragma unroll
        for (unsigned j = 0; j < 16; ++j) { const unsigned c = xb_ld(&bar[XB_XCNT(j)]); sum += c; cnt += (c > 0u) ? 1u : 0u; mine = (j == x) ? c : mine; }
        if (sum == G) break;
        __builtin_amdgcn_s_sleep(1);
        if ((++sp & 255u) == 0u) { if (xb_ld(&bar[XB_TMO])) break; if (sp > XB_SPIN_CAP) { atomicAdd(&bar[XB_TMO], 1u); break; } }
    }
    nloc = mine > 0u ? mine : 1u; nx = cnt > 0u ? cnt : 1u;
}

__device__ __forceinline__ void xcd_barrier(const XcdBarrier& b) {
    asm volatile("s_waitcnt vmcnt(0)" ::: "memory");
    __syncthreads();
    if (threadIdx.x == 0) {
        unsigned* bar = b.bar;
        __builtin_amdgcn_s_waitcnt(0);
        unsigned nloc = b.st[0], nx = b.st[1];
        if (nloc == 0u) { xcd_barrier_complete(bar, b.x, nloc, nx); b.st[0] = nloc; b.st[1] = nx; }
        const unsigned old = xb_add(&bar[XB_XSUB(b.x)], 1u);
        const unsigned gen = old / nloc;
        if (old + 1u == (gen + 1u) * nloc) {
            __builtin_amdgcn_fence(__ATOMIC_RELEASE, "agent");
            asm volatile("s_waitcnt vmcnt(0)" ::: "memory");
            const unsigned og = xb_add(&bar[XB_TOP], 1u);
            const unsigned tg = og / nx;
            if (og + 1u == (tg + 1u) * nx) xb_add(&bar[XB_TOPGEN], 1u);
            else XB_SPIN(xb_ld(&bar[XB_TOPGEN]) == tg, bar);
            __builtin_amdgcn_fence(__ATOMIC_ACQUIRE, "agent");
            xb_add(&bar[XB_XGEN(b.x)], 1u);
            asm volatile("s_waitcnt vmcnt(0)" ::: "memory");
        } else {
            XB_SPIN(xb_ld(&bar[XB_XGEN(b.x)]) == gen, bar);
            __builtin_amdgcn_fence(__ATOMIC_ACQUIRE, "agent");
            asm volatile("s_waitcnt vmcnt(0)" ::: "memory");
        }
    }
    __syncthreads();
}

typedef short bf16x8_t __attribute__((ext_vector_type(8)));
typedef short bf16x4_t __attribute__((ext_vector_type(4)));
constexpr int HG_NSEG = 4, HG_SEGCH = 33;
constexpr int HG_QH = 0, HG_KH = 17408, HG_KP = 34816, HG_VT = 53248, HG_ATT = 71680, HG_TOT = 80896, HG_EBL = 82944;
constexpr int HG_LDA = 136, HG_LDB = 72;

__device__ __forceinline__ bf16x8_t pack8(const f32x4& a, const f32x4& b) {
    u32x4 w; w.x = pg8::cvt_pk_bf16(a.x, a.y); w.y = pg8::cvt_pk_bf16(a.z, a.w); w.z = pg8::cvt_pk_bf16(b.x, b.y); w.w = pg8::cvt_pk_bf16(b.z, b.w);
    return __builtin_bit_cast(bf16x8_t, w);
}
__device__ __forceinline__ bf16x8_t join8(const bf16x4_t a, const bf16x4_t b) { bf16x8_t r; r[0] = a[0]; r[1] = a[1]; r[2] = a[2]; r[3] = a[3]; r[4] = b[0]; r[5] = b[1]; r[6] = b[2]; r[7] = b[3]; return r; }

template <bool OUT>
__device__ __forceinline__ void hgrn_chunk(const bf16_t* __restrict__ p1, long row0, int rstep, int d, int h, float lbk, f32x4 (&S)[8], float& bsum, bf16_t* Obuf, LAS unsigned char* lds) {
    const int tid = threadIdx.x, kc = tid & 127, tg = tid >> 7, w = tid >> 6, lane = tid & 63, fr = lane & 15, fq = lane >> 4;
    LAS bf16_t* QH = (LAS bf16_t*)(lds + HG_QH); LAS bf16_t* KH = (LAS bf16_t*)(lds + HG_KH); LAS bf16_t* KP = (LAS bf16_t*)(lds + HG_KP); LAS bf16_t* VT = (LAS bf16_t*)(lds + HG_VT);
    LAS bf16_t* ATT = (LAS bf16_t*)(lds + HG_ATT); LAS float* TOT = (LAS float*)(lds + HG_TOT); LAS float* EBL = (LAS float*)(lds + HG_EBL);
    float fv[16], qv[16], iv[16];
    { const bf16_t* rp = p1 + (size_t)(row0 + (long)rstep * (16 * tg)) * NIN1 + h * 128 + kc; const long rs = (long)rstep * NIN1; const int fo = d ? 2048 : 1024;
#pragma unroll
      for (int p = 0; p < 16; ++p) { fv[p] = bf2f(rp[fo]); if (OUT) qv[p] = bf2f(rp[0]); iv[p] = bf2f(rp[3072]); rp += rs; } }
    float kvv[16], bl[16]; float run = 0.f;
#pragma unroll
    for (int p = 0; p < 16; ++p) { const float e = __expf(-fv[p]), sg = frcp(1.f + e); const float fg = lbk + (1.f - lbk) * sg; run += __logf(fg); bl[p] = run; kvv[p] = (1.f - lbk) * e * sg; }
    TOT[tg * 128 + kc] = run;
    __syncthreads();
    float prefix = 0.f, blast = 0.f;
#pragma unroll
    for (int g = 0; g < 4; ++g) { const float t = TOT[g * 128 + kc]; blast += t; if (g < tg) prefix += t; }
    {   unsigned kpw[8], vtw[8];
#pragma unroll
        for (int p = 0; p < 16; p += 2) { float kpv[2];
#pragma unroll
            for (int e2 = 0; e2 < 2; ++e2) { const int pp = p + e2; const float b = prefix + bl[pp]; const float eb = __expf(b), ieb = frcp(eb);
                if (OUT) { QH[(16 * tg + pp) * HG_LDA + kc] = f2bf(qv[pp] * eb); KH[(16 * tg + pp) * HG_LDA + kc] = f2bf(kvv[pp] * ieb); }
                kpv[e2] = kvv[pp] * __expf(blast - b); }
            kpw[p >> 1] = pg8::cvt_pk_bf16(kpv[0], kpv[1]); vtw[p >> 1] = pg8::cvt_pk_bf16(iv[p], iv[p + 1]); }
        LAS u32x4* kp4 = (LAS u32x4*)(KP + kc * HG_LDB + 16 * tg); LAS u32x4* vt4 = (LAS u32x4*)(VT + kc * HG_LDB + 16 * tg);
        kp4[0] = (u32x4){kpw[0], kpw[1], kpw[2], kpw[3]}; kp4[1] = (u32x4){kpw[4], kpw[5], kpw[6], kpw[7]};
        vt4[0] = (u32x4){vtw[0], vtw[1], vtw[2], vtw[3]}; vt4[1] = (u32x4){vtw[4], vtw[5], vtw[6], vtw[7]}; }
    if (tg == 0) { EBL[kc] = __expf(blast); bsum += blast; }
    __syncthreads();
    if (OUT) {
#pragma unroll
        for (int q = 0; q < 2; ++q) { const int id = w + 8 * q, st = id >> 2, tt = id & 3;
            f32x4 a = (f32x4){0.f, 0.f, 0.f, 0.f};
            if (st <= tt) {
#pragma unroll
                for (int ks = 0; ks < 4; ++ks) { const bf16x8_t A = *(const LAS bf16x8_t*)(KH + (16 * st + fr) * HG_LDA + 32 * ks + 8 * fq); const bf16x8_t B = *(const LAS bf16x8_t*)(QH + (16 * tt + fr) * HG_LDA + 32 * ks + 8 * fq);
                    a = __builtin_amdgcn_mfma_f32_16x16x32_bf16(A, B, a, 0, 0, 0); }
                if (st == tt) {
#pragma unroll
                    for (int r = 0; r < 4; ++r) if (4 * fq + r > fr) a[r] = 0.f; } }
            u32x2 wv; wv.x = pg8::cvt_pk_bf16(a.x, a.y); wv.y = pg8::cvt_pk_bf16(a.z, a.w);
            *(LAS u32x2*)(ATT + (16 * tt + fr) * HG_LDB + 16 * st + 4 * fq) = wv; }
        __syncthreads();
        f32x4 o[4];
#pragma unroll
        for (int tt = 0; tt < 4; ++tt) o[tt] = (f32x4){0.f, 0.f, 0.f, 0.f};
#pragma unroll
        for (int ks = 0; ks < 4; ++ks) { const bf16x8_t Bs = pack8(S[2 * ks], S[2 * ks + 1]);
#pragma unroll
            for (int tt = 0; tt < 4; ++tt) { const LAS bf16_t* qp = QH + (16 * tt + fr) * HG_LDA + 32 * ks + 4 * fq;
                const bf16x8_t A = join8(*(const LAS bf16x4_t*)qp, *(const LAS bf16x4_t*)(qp + 16));
                o[tt] = __builtin_amdgcn_mfma_f32_16x16x32_bf16(A, Bs, o[tt], 0, 0, 0); } }
#pragma unroll
        for (int sp = 0; sp < 2; ++sp) { const bf16x8_t Bv = *(const LAS bf16x8_t*)(VT + (16 * w + fr) * HG_LDB + 32 * sp + 8 * fq);
#pragma unroll
            for (int tt = 0; tt < 4; ++tt) { if (sp == 1 && tt < 2) continue;
                const bf16x8_t A = *(const LAS bf16x8_t*)(ATT + (16 * tt + fr) * HG_LDB + 32 * sp + 8 * fq);
                o[tt] = __builtin_amdgcn_mfma_f32_16x16x32_bf16(A, Bv, o[tt], 0, 0, 0); } }
#pragma unroll
        for (int tt = 0; tt < 4; ++tt)
#pragma unroll
            for (int r = 0; r < 4; ++r) { const int t = 16 * tt + 4 * fq + r; Obuf[(size_t)(row0 + (long)rstep * t) * DM + h * 128 + 16 * w + fr] = f2bf(o[tt][r]); }
    }
#pragma unroll
    for (int kt = 0; kt < 8; ++kt) { const f32x4 e4 = *(const LAS f32x4*)(EBL + 16 * kt + 4 * fq); S[kt] = S[kt] * e4; }
#pragma unroll
    for (int sp = 0; sp < 2; ++sp) { const bf16x8_t Bv = *(const LAS bf16x8_t*)(VT + (16 * w + fr) * HG_LDB + 32 * sp + 8 * fq);
#pragma unroll
        for (int kt = 0; kt < 8; ++kt) { const bf16x8_t A = *(const LAS bf16x8_t*)(KP + (16 * kt + fr) * HG_LDB + 32 * sp + 8 * fq);
            S[kt] = __builtin_amdgcn_mfma_f32_16x16x32_bf16(A, Bv, S[kt], 0, 0, 0); } }
    __syncthreads();
}

__device__ __forceinline__ void hgrn_chunk_rows(int d, int b, int cc, long& row0, int& rstep) {
    if (cc < 4) { const int t0 = d ? LC - 1 - 64 * cc : 64 * cc; row0 = (long)MLAT + b * LC + t0; }
    else { const int c2 = cc - 4; const int t0 = d ? TL - 1 - 64 * c2 : 64 * c2; row0 = (long)b * TL + t0; }
    rstep = d ? -1 : 1;
}

template <bool PASSC>
__device__ __forceinline__ void ph_hgrn(const MP& p, int bid, int nblk, LAS unsigned char* lds) {
    const bf16_t* p1 = (const bf16_t*)(p.ws + WS_BIG); const float* lbv = (const float*)(p.ws + WS_LB);
    float* SLOC = (float*)(p.ws + WS_SLOC); float* DSEG = (float*)(p.ws + WS_DSEG);
    const int tid = threadIdx.x, kc = tid & 127, tg = tid >> 7, w = tid >> 6, lane = tid & 63, fr = lane & 15, fq = lane >> 4;
    const int nunits = PASSC ? 64 * 4 : 64 * 3;
    for (int u = bid; u < nunits; u += nblk) {
        const int chain = PASSC ? (u >> 2) : (u / 3), seg = PASSC ? (u & 3) : (u % 3);
        const int d = chain >> 5, b = (chain >> 3) & 3, h = chain & 7;
        const float lbk = lbv[h * 128 + kc];
        f32x4 S[8];
#pragma unroll
        for (int kt = 0; kt < 8; ++kt) S[kt] = (f32x4){0.f, 0.f, 0.f, 0.f};
        if (PASSC && seg > 0) {
            for (int jj = 0; jj < seg; ++jj) { const f32x4* sl = (const f32x4*)(SLOC + (size_t)(chain * 3 + jj) * 128 * 128) + (w * 8) * 64 + lane; const float* ds = DSEG + (size_t)(chain * 3 + jj) * 128 + 4 * fq;
#pragma unroll
                for (int kt = 0; kt < 8; ++kt) { f32x4 dd = *(const f32x4*)(ds + 16 * kt); if (jj == 0) dd = (f32x4){0.f, 0.f, 0.f, 0.f}; S[kt] = dd * S[kt] + sl[kt * 64]; } } }
        float bsum = 0.f;
        bf16_t* Obuf = (bf16_t*)(p.ws + (d ? WS_O1 : WS_BUF0));
        for (int ci = 0; ci < HG_SEGCH; ++ci) { const int cc = seg * HG_SEGCH + ci; long row0; int rstep; hgrn_chunk_rows(d, b, cc, row0, rstep);
            if (PASSC && cc >= 4) hgrn_chunk<true>(p1, row0, rstep, d, h, lbk, S, bsum, Obuf, lds);
            else hgrn_chunk<false>(p1, row0, rstep, d, h, lbk, S, bsum, Obuf, lds); }
        if (!PASSC) { f32x4* sl = (f32x4*)(SLOC + (size_t)(chain * 3 + seg) * 128 * 128) + (w * 8) * 64 + lane;
#pragma unroll
            for (int kt = 0; kt < 8; ++kt) sl[kt * 64] = S[kt];
            if (tg == 0) DSEG[(size_t)(chain * 3 + seg) * 128 + kc] = __expf(bsum); }
    }
}
__device__ __forceinline__ void ph_hgrn_out2(const MP& p, int bid, int nblk) {
    bf16_t* o0 = (bf16_t*)(p.ws + WS_BUF0); const bf16_t* o1 = (const bf16_t*)(p.ws + WS_O1); const bf16_t* p1 = (const bf16_t*)(p.ws + WS_BIG); const float* g = p.in[28];
    const int w = threadIdx.x >> 6, lane = threadIdx.x & 63;
    for (int row = bid * 8 + w; row < MLAT; row += nblk * 8) {
        u32x4* a4 = (u32x4*)(o0 + (size_t)row * DM + lane * 16); const u32x4* b4 = (const u32x4*)(o1 + (size_t)row * DM + lane * 16); const u32x4* g4 = (const u32x4*)(p1 + (size_t)row * NIN1 + 4096 + lane * 16);
        float o[16], gt[16]; float s = 0.f;
#pragma unroll
        for (int q = 0; q < 2; ++q) { const u32x4 a = a4[q], bb = b4[q], gg = g4[q];
#pragma unroll
            for (int j = 0; j < 4; ++j) { o[q * 8 + 2 * j] = bfu(a[j], 0) + bfu(bb[j], 0); o[q * 8 + 2 * j + 1] = bfu(a[j], 1) + bfu(bb[j], 1); gt[q * 8 + 2 * j] = bfu(gg[j], 0); gt[q * 8 + 2 * j + 1] = bfu(gg[j], 1); } }
#pragma unroll
        for (int i = 0; i < 16; ++i) s += o[i] * o[i];
        s = wave_sum(s); const float rs = rsqrtf(s * (1.f / 1024.f) + NORM_EPS);
        const f32x4* gn = (const f32x4*)(g + lane * 16);
#pragma unroll
        for (int q = 0; q < 2; ++q) { u32x4 st;
#pragma unroll
            for (int j = 0; j < 4; ++j) { const int i0 = q * 8 + 2 * j; const float y0 = o[i0] * rs * gn[i0 >> 2][i0 & 3] * siluf_(gt[i0]), y1 = o[i0 + 1] * rs * gn[(i0 + 1) >> 2][(i0 + 1) & 3] * siluf_(gt[i0 + 1]); st[j] = pk2(y0, y1); }
            a4[q] = st; }
    }
}

typedef short bf16x4s __attribute__((ext_vector_type(4)));
#ifndef RW_REP
#define RW_REP 0
#endif
constexpr int RW_NCH = 132;
constexpr int RW_P = 72;
__device__ __forceinline__ constexpr int R_AT(int d) { return d * 36864; }
__device__ __forceinline__ constexpr int R_RT(int d) { return d * 36864 + 9216; }
__device__ __forceinline__ constexpr int R_BT(int d) { return d * 36864 + 18432; }
__device__ __forceinline__ constexpr int R_KT(int d) { return d * 36864 + 27648; }
__device__ __forceinline__ constexpr int R_AB(int d) { return 73728 + d * 16384; }
__device__ __forceinline__ constexpr int R_DG(int d) { return 73728 + d * 16384 + 9216; }
__device__ __forceinline__ constexpr int R_TJ(int d) { return 73728 + d * 16384 + 13312; }
constexpr int R_SCR = 106496;
__device__ __forceinline__ constexpr int R_VT(int d) { return 112640 + d * 9216; }
constexpr int R_GG = 131072;
constexpr int R_KN = 139520;
__device__ __forceinline__ constexpr int R_WC(int d) { return 139776 + d * 256; }
constexpr int R_BCP = 140288;
constexpr int R_END = 142336;
constexpr int R_TL = 73728, R_AL = 82944, R_GL = 92160;
constexpr int R_OX = 73728;
constexpr int GGP = 66, GLP = 136;

struct RwkvG {
    unsigned char* MA; unsigned char* ZT0; unsigned char* ZT1; unsigned char* SC;
};
__device__ __forceinline__ RwkvG mk_rwkvg(const MP& p) {
    RwkvG g; unsigned char* t0 = (unsigned char*)p.out; unsigned char* t1 = (unsigned char*)(p.ws + WS_BIG + BIG_P0END);
    const size_t half = (size_t)32 * RW_NCH * 8192;
    g.MA = t0; g.ZT0 = t0 + 2 * half; g.SC = t1; g.ZT1 = t1 + 2 * half; return g; }

__device__ __forceinline__ float lds_f(const LAS unsigned char* lds, int off) { return *(const LAS float*)(lds + off); }
__device__ __forceinline__ f32x4 unpack4(u32x2 w) { f32x4 r; r.x = bfu(w.x, 0); r.y = bfu(w.x, 1); r.z = bfu(w.y, 0); r.w = bfu(w.y, 1); return r; }
__device__ __forceinline__ u32x2 pack4(const f32x4& a) { u32x2 w; w.x = pg8::cvt_pk_bf16(a.x, a.y); w.y = pg8::cvt_pk_bf16(a.z, a.w); return w; }
#define MFMA32(A, B, C) __builtin_amdgcn_mfma_f32_16x16x32_bf16((A), (B), (C), 0, 0, 0)
#define MFMA16(A, B, C) __builtin_amdgcn_mfma_f32_16x16x16bf16_1k((A), (B), (C), 0, 0, 0)
#define LDS_B128(off) (*(const LAS bf16x8_t*)(lds + (off)))
#define LDS_B64(off)  (*(const LAS bf16x4s*)(lds + (off)))
#define CFENCE() asm volatile("" ::: "memory")

__device__ __forceinline__ void ph_lora_w(const MP& p, int bid, int nblk) {
    const float* w_up = p.in[15]; const float* a_up = p.in[17]; const float* g_up = p.in[18];
    bf16_t* WUT = (bf16_t*)(p.ws + WS_LORAW); bf16_t* AUT = WUT + 65536; bf16_t* GUT = AUT + 65536;
    for (int i = bid * 512 + threadIdx.x; i < 196608; i += nblk * 512) {
        if (i < 65536) { const int d = i >> 15, c = (i >> 6) & 511, j = i & 63; WUT[i] = f2bf(w_up[(size_t)(d * 64 + j) * 512 + c]); }
        else if (i < 131072) { const int q = i - 65536, d = q >> 15, c = (q >> 6) & 511, j = q & 63; AUT[q] = f2bf(a_up[(size_t)(d * 64 + j) * 512 + c]); }
        else { const int q = i - 131072, c = q >> 7, j = q & 127; GUT[q] = f2bf(g_up[(size_t)j * 512 + c]); } }
}

__device__ __forceinline__ bf16_t* rw_lin(const MP& p) { return (bf16_t*)((char*)p.out + (size_t)104 * 1024 * 1024); }
__device__ __forceinline__ float* rw_kng(const MP& p) { return (float*)((char*)p.out + (size_t)121 * 1024 * 1024); }
__device__ __forceinline__ float fast_tanh(float x) { return 1.f - 2.f * frcp(1.f + __expf(2.f * x)); }
__device__ __forceinline__ void ph_lora_in(const MP& p, int bid, int nblk) {
    const bf16_t* __restrict__ p0 = (const bf16_t*)(p.ws + WS_BIG); const float* mu_prev = p.in[12]; const float* mu_next = p.in[13]; const float* k_k = p.in[19];
    bf16_t* LIN = rw_lin(p); float* KNG = rw_kng(p);
    const int tid = threadIdx.x;
    for (int blk = bid; blk < NB * RW_NCH; blk += nblk) {
        const int tc = blk % RW_NCH, b = blk / RW_NCH; const bool isctx = tc < 4; const int tcl = isctx ? tc : tc - 4, slen = isctx ? LC : TL;
        const long base_row = isctx ? (long)MLAT + b * LC + 64 * tcl : (long)b * TL + 64 * tcl; const int tseq0 = 64 * tcl;
        {   const int col = tid & 255, th = tid >> 8; const int pc = 1536 + col; const float mup = mu_prev[pc], mun = mu_next[pc];
            const bf16_t* rp = p0 + (size_t)(base_row + 32 * th) * NIN0 + pc;
            float xs[34];
#pragma unroll
            for (int i = 0; i < 34; ++i) { const int ts = tseq0 + 32 * th - 1 + i; xs[i] = (ts >= 0 && ts < slen) ? bf2f(rp[(long)(i - 1) * NIN0]) : 0.f; }
#pragma unroll
            for (int i = 0; i < 32; ++i) { const float x = xs[i + 1]; const float s = x + (xs[i] - x) * mup + (xs[i + 2] - x) * mun;
                const float y = col < 64 ? fast_tanh(s) : (col < 128 ? s : sigmoidf_(s));
                LIN[(size_t)(base_row + 32 * th + i) * 256 + col] = f2bf(y); } }
        {   const int tok = tid >> 3, c0 = (tid & 7) * 8; const bool hp = tseq0 + tok > 0, hn = tseq0 + tok < slen - 1;
#pragma unroll 2
            for (int h = 0; h < 8; ++h) { const int pc = 512 + h * 64 + c0; const bf16_t* rp = p0 + (size_t)(base_row + tok) * NIN0 + pc;
                const u32x4 x4 = *(const u32x4*)rp; u32x4 p4 = (u32x4){0u, 0u, 0u, 0u}, n4 = (u32x4){0u, 0u, 0u, 0u};
                if (hp) p4 = *(const u32x4*)(rp - (long)NIN0); if (hn) n4 = *(const u32x4*)(rp + NIN0);
                float s = 0.f;
#pragma unroll
                for (int j = 0; j < 8; ++j) { const float x = bfu(x4[j >> 1], j & 1), xp = bfu(p4[j >> 1], j & 1), xn = bfu(n4[j >> 1], j & 1);
                    const float kv = (x + (xp - x) * mu_prev[pc + j] + (xn - x) * mu_next[pc + j]) * k_k[h * 64 + c0 + j]; s += kv * kv; }
                s += __shfl_xor(s, 1); s += __shfl_xor(s, 2); s += __shfl_xor(s, 4);
                if ((tid & 7) == 0) KNG[(size_t)(base_row + tok) * 8 + h] = 1.f / fmaxf(sqrtf(s), 1e-12f); } }
    }
}

template <int MODE>
__device__ __forceinline__ void rwkv_unit(const MP& p, int u, LAS unsigned char* lds) {
    const bf16_t* __restrict__ p0 = (const bf16_t*)(p.ws + WS_BIG);
    const float* mu_prev = p.in[12]; const float* mu_next = p.in[13]; const float* w0 = p.in[14]; const float* a0 = p.in[16];
    const float* k_k = p.in[19]; const float* k_a = p.in[20]; const float* r_k = p.in[21]; const float* ln_g = p.in[22]; const float* ln_b = p.in[23];
    const bf16_t* WUT = (const bf16_t*)(p.ws + WS_LORAW); const bf16_t* AUT = WUT + 65536; const bf16_t* GUT = AUT + 65536;
    const RwkvG RG = mk_rwkvg(p);
    int tid_ = threadIdx.x; asm volatile("" : "+v"(tid_));
    const int tid = tid_, w = __builtin_amdgcn_readfirstlane(tid >> 6), lane = tid & 63, fr = lane & 15, fq = lane >> 4;
    const int h = u & 7, tc = (u >> 3) % RW_NCH, b = u / (8 * RW_NCH);
    const bool isctx = tc < 4; const int tcl = isctx ? tc : tc - 4, slen = isctx ? LC : TL;
    const long base_row = isctx ? (long)MLAT + b * LC + 64 * tcl : (long)b * TL + 64 * tcl;
    const int tseq0 = 64 * tcl;

    const int d = w >> 2, ct = w & 3;
    const int hc = h * 64 + 16 * ct + fr;
    float xr[4][6], xk[4][6], xv[4][6];
#pragma unroll
    for (int tt = 0; tt < 4; ++tt) { const int tok0 = 16 * tt + 4 * fq; const bf16_t* rp = p0 + (size_t)(base_row + tok0) * NIN0 + hc;
#pragma unroll
        for (int i = 0; i < 6; ++i) { const int ts = tseq0 + tok0 - 1 + i; const bool ok = ts >= 0 && ts < slen; const bf16_t* q = rp + (long)(ok ? i - 1 : 0) * NIN0;
            const float a_ = bf2f(q[0]), b_ = bf2f(q[512]), c_ = bf2f(q[1024]); xr[tt][i] = ok ? a_ : 0.f; xk[tt][i] = ok ? b_ : 0.f; xv[tt][i] = ok ? c_ : 0.f; } }
    const bf16_t* LIN = rw_lin(p) + (size_t)base_row * 256; const float* KNG = rw_kng(p) + (size_t)base_row * 8 + h;
    f32x4 kn[4];
#pragma unroll
    for (int tt = 0; tt < 4; ++tt)
#pragma unroll
        for (int r = 0; r < 4; ++r) kn[tt][r] = KNG[(size_t)(16 * tt + 4 * fq + r) * 8];
    u32x2 bhp[4], khp[4];
    for (int rep_ = 0; rep_ < (RW_REP == 1 ? 2 : 1); ++rep_)
    {
        f32x4 wl[4], al[4];
        {   bf16x8_t Bw[2], Ba[2];
#pragma unroll
            for (int ks = 0; ks < 2; ++ks) { Bw[ks] = *(const bf16x8_t*)(WUT + (size_t)(d * 512 + hc) * 64 + 32 * ks + 8 * fq); Ba[ks] = *(const bf16x8_t*)(AUT + (size_t)(d * 512 + hc) * 64 + 32 * ks + 8 * fq); }
            const float w0v = w0[d * 512 + hc], a0v = a0[d * 512 + hc];
#pragma unroll
            for (int tt = 0; tt < 4; ++tt) { f32x4 aw = (f32x4){w0v, w0v, w0v, w0v}, aa = (f32x4){a0v, a0v, a0v, a0v};
#pragma unroll
                for (int ks = 0; ks < 2; ++ks) { aw = MFMA32(*(const bf16x8_t*)(LIN + (size_t)(16 * tt + fr) * 256 + 32 * ks + 8 * fq), Bw[ks], aw); aa = MFMA32(*(const bf16x8_t*)(LIN + (size_t)(16 * tt + fr) * 256 + 64 + 32 * ks + 8 * fq), Ba[ks], aa); }
                wl[tt] = aw; al[tt] = aa; } }
        if (MODE == 1) {
#pragma unroll
            for (int q = 0; q < 2; ++q) { const int id = 2 * w + q, tt = id >> 2, cg = id & 3; f32x4 ag = (f32x4){0.f, 0.f, 0.f, 0.f};
#pragma unroll
                for (int ks = 0; ks < 4; ++ks) ag = MFMA32(*(const bf16x8_t*)(LIN + (size_t)(16 * tt + fr) * 256 + 128 + 32 * ks + 8 * fq), *(const bf16x8_t*)(GUT + (size_t)(h * 64 + 16 * cg + fr) * 128 + 32 * ks + 8 * fq), ag);
#pragma unroll
                for (int r = 0; r < 4; ++r) *(LAS bf16_t*)(lds + R_GG + ((16 * tt + 4 * fq + r) * GGP + 16 * cg + fr) * 2) = f2bf(ag[r]); } }
        f32x4 lw[4]; float base[4]; float cumC;
        {   float pre[4], tot[4];
#pragma unroll
            for (int tt = 0; tt < 4; ++tt) {
#pragma unroll
                for (int r = 0; r < 4; ++r) lw[tt][r] = -0.60653066f * frcp(1.f + __expf(-wl[tt][r]));
                const float s4 = (lw[tt][0] + lw[tt][1]) + (lw[tt][2] + lw[tt][3]);
                const float u1 = __shfl(s4, (lane + 16) & 63), u2 = __shfl(s4, (lane + 32) & 63), u3 = __shfl(s4, (lane + 48) & 63);
                tot[tt] = (s4 + u1) + (u2 + u3);
                float pr = 0.f;
                if (d == 0) { if (fq >= 1) pr += u3; if (fq >= 2) pr += u2; if (fq >= 3) pr += u1; }
                else        { if (fq <= 2) pr += u1; if (fq <= 1) pr += u2; if (fq <= 0) pr += u3; }
                pre[tt] = pr; }
            cumC = (tot[0] + tot[1]) + (tot[2] + tot[3]);
            base[0] = pre[0] + (d ? (tot[1] + tot[2] + tot[3]) : 0.f); base[1] = pre[1] + (d ? (tot[2] + tot[3]) : tot[0]);
            base[2] = pre[2] + (d ? tot[3] : (tot[0] + tot[1])); base[3] = pre[3] + (d ? 0.f : (tot[0] + tot[1] + tot[2])); }
        const float mpr = mu_prev[hc], mnr = mu_next[hc], mpk = mu_prev[512 + hc], mnk = mu_next[512 + hc], mpv = mu_prev[1024 + hc], mnv = mu_next[1024 + hc];
        const float kkc = k_k[hc], kac = k_a[hc], rkc = r_k[hc];
#pragma unroll
        for (int tt = 0; tt < 4; ++tt) { const int tok0 = 16 * tt + 4 * fq;
            f32x4 cum;
            { const float a0_ = lw[tt][0], a1_ = lw[tt][1], a2_ = lw[tt][2], a3_ = lw[tt][3];
              if (d == 0) { cum[0] = base[tt] + a0_; cum[1] = cum[0] + a1_; cum[2] = cum[1] + a2_; cum[3] = cum[2] + a3_; }
              else        { cum[3] = base[tt] + a3_; cum[2] = cum[3] + a2_; cum[1] = cum[2] + a1_; cum[0] = cum[1] + a0_; } }
            f32x4 vv, bh4, kh4;
#pragma unroll
            for (int r = 0; r < 4; ++r) { const float rs = xr[tt][r + 1] + (xr[tt][r] - xr[tt][r + 1]) * mpr + (xr[tt][r + 2] - xr[tt][r + 1]) * mnr;
                const float ks_ = xk[tt][r + 1] + (xk[tt][r] - xk[tt][r + 1]) * mpk + (xk[tt][r + 2] - xk[tt][r + 1]) * mnk;
                vv[r] = xv[tt][r + 1] + (xv[tt][r] - xv[tt][r + 1]) * mpv + (xv[tt][r + 2] - xv[tt][r + 1]) * mnv;
                const int tok = tok0 + r, pos = d ? 63 - tok : tok;
                const float kk = ks_ * kkc * kn[tt][r];
                const float a = sigmoidf_(al[tt][r]);
                const float kdv = ks_ * (1.f + (a - 1.f) * kac), bbv = kk * a;
                const float c = cum[r], ec = __expf(c), en = frcp(ec), ep = __expf(c - lw[tt][r]), eh = __expf(cumC - c);
                const int o = (pos * RW_P + 16 * ct + fr) * 2;
                *(LAS bf16_t*)(lds + R_AT(0) + d * 36864 + o) = f2bf(-kk * ep);
                *(LAS bf16_t*)(lds + R_BT(0) + d * 36864 + o) = f2bf(bbv * en);
                *(LAS bf16_t*)(lds + R_KT(0) + d * 36864 + o) = f2bf(kdv * en);
                if (MODE == 1) *(LAS bf16_t*)(lds + R_RT(0) + d * 36864 + o) = f2bf(rs * ec);
                bh4[r] = bbv * eh; kh4[r] = kdv * eh;
                if (MODE == 1) { float s = rs * rkc * kdv; s += __shfl_xor(s, 1); s += __shfl_xor(s, 2); s += __shfl_xor(s, 4); s += __shfl_xor(s, 8);
                    if (fr == 0) *(LAS float*)(lds + R_BCP + ((d * 4 + ct) * 64 + tok) * 4) = s; } }
            { f32x4 vo = vv; if (d) vo = (f32x4){vv[3], vv[2], vv[1], vv[0]}; const int pos0 = d ? 63 - (tok0 + 3) : tok0;
              *(LAS u32x2*)(lds + R_VT(0) + d * 9216 + ((16 * ct + fr) * RW_P + pos0) * 2) = pack4(vo); }
            if (MODE == 0) { if (d) { bh4 = (f32x4){bh4[3], bh4[2], bh4[1], bh4[0]}; kh4 = (f32x4){kh4[3], kh4[2], kh4[1], kh4[0]}; } bhp[tt] = pack4(bh4); khp[tt] = pack4(kh4); }
        }
        if (MODE == 0 && fq == 0) *(LAS float*)(lds + R_WC(0) + d * 256 + (16 * ct + fr) * 4) = __expf(cumC);
    }
    __syncthreads();

    f32x4 yak[2][4];
    f32x4 akr[4]; u32x2 abr[4];
    for (int rep_ = 0; rep_ < (RW_REP == 2 ? 2 : 1); ++rep_)
    {
        const int I = w & 3;
#pragma unroll
        for (int dd = 0; dd < 2; ++dd) {
            const int rowbase = (w < 4 ? R_BT(0) : R_KT(0)) + dd * 36864;
            bf16x8_t A0 = LDS_B128(rowbase + ((16 * I + fr) * RW_P + 8 * fq) * 2), A1 = LDS_B128(rowbase + ((16 * I + fr) * RW_P + 32 + 8 * fq) * 2);
#pragma unroll
            for (int J = 0; J < 4; ++J) { f32x4 acc = (f32x4){0.f, 0.f, 0.f, 0.f};
                if (J >= I) { acc = MFMA32(A0, LDS_B128(R_AT(0) + dd * 36864 + ((16 * J + fr) * RW_P + 8 * fq) * 2), acc); acc = MFMA32(A1, LDS_B128(R_AT(0) + dd * 36864 + ((16 * J + fr) * RW_P + 32 + 8 * fq) * 2), acc); }
                if (J == I) {
#pragma unroll
                    for (int r = 0; r < 4; ++r) if (!(4 * fq + r < fr)) acc[r] = 0.f; }
                if (w < 4) {
                    if (J == I) {
#pragma unroll
                        for (int r = 0; r < 4; ++r) *(LAS float*)(lds + R_DG(0) + dd * 16384 + ((J * 16 + 4 * fq + r) * 16 + fr) * 4) = acc[r];
                        acc = (f32x4){0.f, 0.f, 0.f, 0.f}; }
                    *(LAS u32x2*)(lds + R_AB(0) + dd * 16384 + ((16 * J + fr) * RW_P + 16 * I + 4 * fq) * 2) = pack4(acc);
                } else yak[dd][J] = acc; } }
        if (MODE == 1) {
            const int J = ct;
            const bf16x8_t B0 = LDS_B128(R_RT(0) + d * 36864 + ((16 * J + fr) * RW_P + 8 * fq) * 2), B1 = LDS_B128(R_RT(0) + d * 36864 + ((16 * J + fr) * RW_P + 32 + 8 * fq) * 2);
#pragma unroll
            for (int I2 = 0; I2 < 4; ++I2) { f32x4 a1 = (f32x4){0.f, 0.f, 0.f, 0.f}, a2 = (f32x4){0.f, 0.f, 0.f, 0.f};
                if (I2 <= J) {
                    a1 = MFMA32(LDS_B128(R_BT(0) + d * 36864 + ((16 * I2 + fr) * RW_P + 8 * fq) * 2), B0, a1); a1 = MFMA32(LDS_B128(R_BT(0) + d * 36864 + ((16 * I2 + fr) * RW_P + 32 + 8 * fq) * 2), B1, a1);
                    a2 = MFMA32(LDS_B128(R_KT(0) + d * 36864 + ((16 * I2 + fr) * RW_P + 8 * fq) * 2), B0, a2); a2 = MFMA32(LDS_B128(R_KT(0) + d * 36864 + ((16 * I2 + fr) * RW_P + 32 + 8 * fq) * 2), B1, a2); }
                if (I2 == J) {
#pragma unroll
                    for (int r = 0; r < 4; ++r) if (!(4 * fq + r <= fr)) { a1[r] = 0.f; a2[r] = 0.f; } }
                abr[I2] = pack4(a1); akr[I2] = a2; } }
    }
    __syncthreads();

    for (int rep_ = 0; rep_ < (RW_REP == 3 ? 2 : 1); ++rep_)
    {   const int J = ct; float T[16];
#pragma unroll
        for (int t = 0; t < 16; ++t) { float acc = (fr == t) ? 1.f : 0.f;
#pragma unroll
            for (int i = 0; i < t; ++i) acc += T[i] * lds_f(lds, R_DG(0) + d * 16384 + ((J * 16 + i) * 16 + t) * 4);
            T[t] = acc; }
        if (fq == 0) {
#pragma unroll
            for (int t = 0; t < 16; ++t) *(LAS bf16_t*)(lds + R_TJ(0) + d * 16384 + ((J * 16 + t) * 24 + fr) * 2) = f2bf(T[t]); }
    }
    __syncthreads();

    for (int rep_ = 0; rep_ < (RW_REP == 4 ? 2 : 1); ++rep_)
#pragma unroll
    for (int dd = 0; dd < 2; ++dd) {
        f32x4 R[4];
#pragma unroll
        for (int J = 0; J < 4; ++J) { if (w < 4) R[J] = unpack4(*(const LAS u32x2*)(lds + R_AT(0) + dd * 36864 + ((16 * J + fr) * RW_P + 16 * w + 4 * fq) * 2)); else R[J] = yak[dd][J]; }
        const int xrow = R_BT(0) + dd * 36864 + (16 * w + fr) * RW_P * 2;
#pragma unroll
        for (int J = 0; J < 4; ++J) {
            if (J >= 1) {
#pragma unroll
                for (int ks = 0; ks < (J + 1) / 2; ++ks) R[J] = MFMA32(LDS_B128(xrow + (32 * ks + 8 * fq) * 2), LDS_B128(R_AB(0) + dd * 16384 + ((16 * J + fr) * RW_P + 32 * ks + 8 * fq) * 2), R[J]); }
            CFENCE();
#pragma unroll
            for (int r = 0; r < 4; ++r) *(LAS bf16_t*)(lds + R_SCR + w * 768 + ((4 * fq + r) * 24 + fr) * 2) = f2bf(R[J][r]);
            CFENCE();
            const bf16x4s Ax = LDS_B64(R_SCR + w * 768 + (fr * 24 + 4 * fq) * 2), Bx = LDS_B64(R_TJ(0) + dd * 16384 + ((J * 16 + fr) * 24 + 4 * fq) * 2);
            const f32x4 X = MFMA16(Ax, Bx, ((f32x4){0.f, 0.f, 0.f, 0.f}));
            CFENCE();
#pragma unroll
            for (int r = 0; r < 4; ++r) *(LAS bf16_t*)(lds + R_BT(0) + dd * 36864 + ((16 * w + 4 * fq + r) * RW_P + 16 * J + fr) * 2) = f2bf(X[r]);
            CFENCE();
        }
    }
    __syncthreads();

    const int sc = (d == 0) ? tc : (isctx ? 3 - tc : 135 - tc);
    const size_t cidx = (size_t)((d * 32 + b * 8 + h) * RW_NCH + sc);
    if (MODE == 0) {
#pragma unroll
        for (int tt = 0; tt < 4; ++tt) { const int pos0 = d ? 63 - (16 * tt + 4 * fq + 3) : 16 * tt + 4 * fq;
            *(LAS u32x2*)(lds + R_AT(0) + d * 36864 + ((16 * ct + fr) * RW_P + pos0) * 2) = bhp[tt]; *(LAS u32x2*)(lds + R_AB(0) + d * 16384 + ((16 * ct + fr) * RW_P + pos0) * 2) = khp[tt]; }
        __syncthreads();
        const int BH = R_AT(0) + d * 36864, KH = R_AB(0) + d * 16384, XB = R_BT(0) + d * 36864, kt2 = ct;
        const bf16x8_t Bb0 = LDS_B128(BH + ((16 * kt2 + fr) * RW_P + 8 * fq) * 2), Bb1 = LDS_B128(BH + ((16 * kt2 + fr) * RW_P + 32 + 8 * fq) * 2);
        f32x4 Mt[4], Nt[4];
        const float wcv = lds_f(lds, R_WC(0) + d * 256 + (16 * kt2 + fr) * 4);
#pragma unroll
        for (int kt = 0; kt < 4; ++kt) { f32x4 acc = (f32x4){0.f, 0.f, 0.f, 0.f};
            if (kt == kt2) {
#pragma unroll
                for (int r = 0; r < 4; ++r) if (4 * fq + r == fr) acc[r] = wcv; }
            acc = MFMA32(LDS_B128(XB + ((16 * kt + fr) * RW_P + 8 * fq) * 2), Bb0, acc); acc = MFMA32(LDS_B128(XB + ((16 * kt + fr) * RW_P + 32 + 8 * fq) * 2), Bb1, acc); Mt[kt] = acc;
            f32x4 an = unpack4(*(const LAS u32x2*)(lds + KH + ((16 * kt2 + fr) * RW_P + 16 * kt + 4 * fq) * 2));
            an = MFMA32(LDS_B128(XB + ((64 + 16 * kt + fr) * RW_P + 8 * fq) * 2), Bb0, an); an = MFMA32(LDS_B128(XB + ((64 + 16 * kt + fr) * RW_P + 32 + 8 * fq) * 2), Bb1, an); Nt[kt] = an; }
        unsigned char* ma = RG.MA + cidx * 8192;
#pragma unroll
        for (int s = 0; s < 2; ++s) *(bf16x8_t*)(ma + ((kt2 * 2 + s) * 64 + lane) * 16) = pack8(Mt[2 * s], Mt[2 * s + 1]);
        unsigned char* zt = (d == 0 ? RG.ZT0 : RG.ZT1) + (cidx - (size_t)d * 32 * RW_NCH) * 8192;
        const bf16x8_t An0 = pack8(Nt[0], Nt[1]), An1 = pack8(Nt[2], Nt[3]);
        const int VT = R_VT(0) + d * 9216;
#pragma unroll
        for (int vt = 0; vt < 4; ++vt) { f32x4 z = (f32x4){0.f, 0.f, 0.f, 0.f}; const int vo = VT + ((16 * vt + fr) * RW_P + 4 * fq) * 2;
            z = MFMA32(An0, join8(LDS_B64(vo), LDS_B64(vo + 32)), z); z = MFMA32(An1, join8(LDS_B64(vo + 64), LDS_B64(vo + 96)), z);
            *(u32x2*)(zt + ((kt2 * 4 + vt) * 64 + lane) * 8) = pack4(z); }
    } else {
        const int J = ct;
#pragma unroll
        for (int I2 = 0; I2 < 4; ++I2) *(LAS u32x2*)(lds + R_AT(0) + d * 36864 + ((16 * J + fr) * RW_P + 16 * I2 + 4 * fq) * 2) = abr[I2];
        __syncthreads();
        const int ABR = R_AT(0) + d * 36864, XB = R_BT(0) + d * 36864, RT = R_RT(0) + d * 36864;
        const bf16x8_t Bb0 = LDS_B128(ABR + ((16 * J + fr) * RW_P + 8 * fq) * 2), Bb1 = LDS_B128(ABR + ((16 * J + fr) * RW_P + 32 + 8 * fq) * 2);
        f32x4 Qt[4], Gt[4];
#pragma unroll
        for (int kt = 0; kt < 4; ++kt) { f32x4 acc = unpack4(*(const LAS u32x2*)(lds + RT + ((16 * J + fr) * RW_P + 16 * kt + 4 * fq) * 2));
            acc = MFMA32(LDS_B128(XB + ((16 * kt + fr) * RW_P + 8 * fq) * 2), Bb0, acc); acc = MFMA32(LDS_B128(XB + ((16 * kt + fr) * RW_P + 32 + 8 * fq) * 2), Bb1, acc); Qt[kt] = acc;
            f32x4 ag = akr[kt];
            ag = MFMA32(LDS_B128(XB + ((64 + 16 * kt + fr) * RW_P + 8 * fq) * 2), Bb0, ag); ag = MFMA32(LDS_B128(XB + ((64 + 16 * kt + fr) * RW_P + 32 + 8 * fq) * 2), Bb1, ag); Gt[kt] = ag; }
        const bf16x8_t Aq0 = pack8(Qt[0], Qt[1]), Aq1 = pack8(Qt[2], Qt[3]), Ag0 = pack8(Gt[0], Gt[1]), Ag1 = pack8(Gt[2], Gt[3]);
        const unsigned char* scp = RG.SC + cidx * 8192; const int VT = R_VT(0) + d * 9216;
        f32x4 Ot[4];
#pragma unroll
        for (int vt = 0; vt < 4; ++vt) { f32x4 o = (f32x4){0.f, 0.f, 0.f, 0.f}; const int vo = VT + ((16 * vt + fr) * RW_P + 4 * fq) * 2;
            o = MFMA32(Aq0, *(const bf16x8_t*)(scp + ((vt * 2 + 0) * 64 + lane) * 16), o); o = MFMA32(Aq1, *(const bf16x8_t*)(scp + ((vt * 2 + 1) * 64 + lane) * 16), o);
            o = MFMA32(Ag0, join8(LDS_B64(vo), LDS_B64(vo + 32)), o); o = MFMA32(Ag1, join8(LDS_B64(vo + 64), LDS_B64(vo + 96)), o); Ot[vt] = o; }
        __syncthreads();
#pragma unroll
        for (int vt = 0; vt < 4; ++vt)
#pragma unroll
            for (int r = 0; r < 4; ++r) { const int pos = 16 * J + 4 * fq + r, tok = d ? 63 - pos : pos; *(LAS float*)(lds + R_OX + ((d * 64 + tok) * 65 + 16 * vt + fr) * 4) = Ot[vt][r]; }
        __syncthreads();
        {   const int tok = tid >> 3, c0 = (tid & 7) * 8; float o[8]; float s = 0.f;
#pragma unroll
            for (int j = 0; j < 8; ++j) { o[j] = lds_f(lds, R_OX + (tok * 65 + c0 + j) * 4) + lds_f(lds, R_OX + ((64 + tok) * 65 + c0 + j) * 4); s += o[j]; }
            s += __shfl_xor(s, 1); s += __shfl_xor(s, 2); s += __shfl_xor(s, 4); const float mu = s * (1.f / 64.f); float q = 0.f;
#pragma unroll
            for (int j = 0; j < 8; ++j) { const float dl = o[j] - mu; q += dl * dl; }
            q += __shfl_xor(q, 1); q += __shfl_xor(q, 2); q += __shfl_xor(q, 4); const float rs = rsqrtf(q * (1.f / 64.f) + 64e-5f);
            float bc = 0.f;
#pragma unroll
            for (int i = 0; i < 8; ++i) bc += lds_f(lds, R_BCP + (i * 64 + tok) * 4);
            unsigned pk[4];
#pragma unroll
            for (int j = 0; j < 8; j += 2) { float y[2];
#pragma unroll
                for (int e = 0; e < 2; ++e) { const int c = c0 + j + e; const float vv = bf2f(*(const LAS bf16_t*)(lds + R_VT(0) + (c * RW_P + tok) * 2)), gg = bf2f(*(const LAS bf16_t*)(lds + R_GG + (tok * GGP + c) * 2));
                    y[e] = ((o[j + e] - mu) * rs * ln_g[h * 64 + c] + ln_b[h * 64 + c] + bc * vv) * gg; }
                pk[j >> 1] = pg8::cvt_pk_bf16(y[0], y[1]); }
            bf16_t* mix = (bf16_t*)(p.ws + WS_BUF0);
            *(u32x4*)(mix + (size_t)(base_row + tok) * DM + h * 64 + c0) = (u32x4){pk[0], pk[1], pk[2], pk[3]}; }
    }
    __syncthreads();
}

template <int MODE>
__device__ __forceinline__ void ph_rwkv(const MP& p, int bid, int nblk, LAS unsigned char* lds) {
    constexpr int NU = NB * RW_NCH * 8;
    for (int u = bid; u < NU; u += nblk) rwkv_unit<MODE>(p, u, lds);
}

__device__ __forceinline__ void ph_rwkv_scan2(const MP& p, int bid, int nblk) {
    if (threadIdx.x >= 64) return;
    const RwkvG RG = mk_rwkvg(p); const int lane = threadIdx.x;
    for (int task = bid; task < 256; task += nblk) {
        const int chain = (task & 7) + 8 * (task >> 5), vt = (task >> 3) & 3;
        const unsigned char* ma = RG.MA + (size_t)chain * RW_NCH * 8192;
        const unsigned char* zt = (chain < 32 ? RG.ZT0 + (size_t)chain * RW_NCH * 8192 : RG.ZT1 + (size_t)(chain - 32) * RW_NCH * 8192);
        unsigned char* scp = RG.SC + (size_t)chain * RW_NCH * 8192;
        f32x4 St[4];
#pragma unroll
        for (int k = 0; k < 4; ++k) St[k] = (f32x4){0.f, 0.f, 0.f, 0.f};
        bf16x8_t mA[4][2], nA[4][2]; u32x2 zA[4], nz[4];
#pragma unroll
        for (int k = 0; k < 4; ++k) { zA[k] = *(const u32x2*)(zt + ((k * 4 + vt) * 64 + lane) * 8); nz[k] = zA[k];
#pragma unroll
            for (int s = 0; s < 2; ++s) { mA[k][s] = *(const bf16x8_t*)(ma + ((k * 2 + s) * 64 + lane) * 16); nA[k][s] = mA[k][s]; } }
        for (int c = 0; c < RW_NCH; ++c) {
            if (c + 1 < RW_NCH) { const unsigned char* ma2 = ma + (size_t)(c + 1) * 8192; const unsigned char* zt2 = zt + (size_t)(c + 1) * 8192;
#pragma unroll
                for (int k = 0; k < 4; ++k) { nz[k] = *(const u32x2*)(zt2 + ((k * 4 + vt) * 64 + lane) * 8);
#pragma unroll
                    for (int s = 0; s < 2; ++s) nA[k][s] = *(const bf16x8_t*)(ma2 + ((k * 2 + s) * 64 + lane) * 16); } }
            const bf16x8_t B0 = pack8(St[0], St[1]), B1 = pack8(St[2], St[3]);
            unsigned char* so = scp + (size_t)c * 8192;
            *(bf16x8_t*)(so + ((vt * 2 + 0) * 64 + lane) * 16) = B0; *(bf16x8_t*)(so + ((vt * 2 + 1) * 64 + lane) * 16) = B1;
#pragma unroll
            for (int k = 0; k < 4; ++k) { f32x4 acc = unpack4(zA[k]); acc = MFMA32(mA[k][0], B0, acc); acc = MFMA32(mA[k][1], B1, acc); St[k] = acc; }
#pragma unroll
            for (int k = 0; k < 4; ++k) { zA[k] = nz[k]; mA[k][0] = nA[k][0]; mA[k][1] = nA[k][1]; }
        }
    }
}

constexpr size_t WS_VTL = WS_WTL0 + (size_t)26 * 1024 * 1024;
constexpr size_t WS_VTC = WS_SLOC;
static_assert(WS_WT + WT_L0END <= WS_VTL && WS_VTL + (size_t)32 * 64 * 8192 * 2 <= WS_SLOC, "VT layout");

template <bool WIN>
__device__ __forceinline__ void na_block(const bf16_t* __restrict__ p0, const bf16_t* __restrict__ vt, const LAS float* rpbl, const bf16x8_t (&Qf)[2], f32x4 (&O)[4], float& m_run, float& l_run,
                                         int krow0  , int h, size_t vtrow  , int vtld,
                                         int rq_minus_r0  , int cq, int cs, int fr, int fq) {
    f32x4 S[16];
#pragma unroll
    for (int ti = 0; ti < 16; ++ti) { const int krow = WIN ? krow0 + (ti >> 1) * 64 + (ti & 1) * 16 + fr : krow0 + 16 * ti + fr;
        const bf16_t* kp = p0 + (size_t)krow * NIN0 + 2304 + h * 64 + 8 * fq;
        f32x4 acc = (f32x4){0.f, 0.f, 0.f, 0.f};
        acc = MFMA32(*(const bf16x8_t*)kp, Qf[0], acc); acc = MFMA32(*(const bf16x8_t*)(kp + 32), Qf[1], acc);
        S[ti] = acc; }
    float mx = -1e30f;
    if (WIN) { const int c0q = min(max(cq - 8, 0), 48);
#pragma unroll
        for (int ti = 0; ti < 16; ++ti) { const int kr = ti >> 1; const int rr = kr - rq_minus_r0 + 7;
#pragma unroll
            for (int r = 0; r < 4; ++r) { const int kc = cs + (ti & 1) * 16 + 4 * fq + r; const bool ok = kc >= c0q && kc <= c0q + 15;
                const float bias = ok ? rpbl[rr * 31 + (kc - cq + 15)] : 0.f;
                const float s = ok ? S[ti][r] * 0.125f + bias : -1e30f; S[ti][r] = s; mx = fmaxf(mx, s); } }
    } else {
#pragma unroll
        for (int ti = 0; ti < 16; ++ti)
#pragma unroll
            for (int r = 0; r < 4; ++r) { const float s = S[ti][r] * 0.125f; S[ti][r] = s; mx = fmaxf(mx, s); } }
    mx = fmaxf(mx, __shfl_xor(mx, 16)); mx = fmaxf(mx, __shfl_xor(mx, 32));
    const float m_new = fmaxf(m_run, mx), sc = __expf(m_run - m_new);
    float ls = 0.f;
#pragma unroll
    for (int ti = 0; ti < 16; ++ti)
#pragma unroll
        for (int r = 0; r < 4; ++r) { const float pv = __expf(S[ti][r] - m_new); S[ti][r] = pv; ls += pv; }
    ls += __shfl_xor(ls, 16); ls += __shfl_xor(ls, 32);
    l_run = l_run * sc + ls; m_run = m_new;
#pragma unroll
    for (int dt = 0; dt < 4; ++dt) O[dt] = O[dt] * sc;
#pragma unroll
    for (int s = 0; s < 8; ++s) { const bf16x8_t Pb = pack8(S[2 * s], S[2 * s + 1]);
        const size_t ko = WIN ? (size_t)s * 64 + 4 * fq : (size_t)s * 32 + 4 * fq;
#pragma unroll
        for (int dt = 0; dt < 4; ++dt) { const bf16_t* vp = vt + vtrow + (size_t)(16 * dt + fr) * vtld + ko;
            const bf16x8_t Av = join8(*(const bf16x4_t*)vp, *(const bf16x4_t*)(vp + 16));
            O[dt] = MFMA32(Av, Pb, O[dt]); } }
}

__device__ __forceinline__ void ph_na2(const MP& p, int bid, int nblk, LAS unsigned char* lds) {
    const bf16_t* __restrict__ p0 = (const bf16_t*)(p.ws + WS_BIG); const bf16_t* vtl = (const bf16_t*)(p.ws + WS_VTL); const bf16_t* vtc = (const bf16_t*)(p.ws + WS_VTC);
    const float* rpb = p.in[24]; bf16_t* mix = (bf16_t*)(p.ws + WS_BUF0);
    int tid_ = threadIdx.x; asm volatile("" : "+v"(tid_));
    const int tid = tid_, w = __builtin_amdgcn_readfirstlane(tid >> 6), lane = tid & 63, fr = lane & 15, fq = lane >> 4;
    LAS float* rpbl = (LAS float*)(lds + w * 2048);
    const int gw = bid * 8 + w, NW = nblk * 8;
    constexpr int NLAT = NB * 8 * 128 * 4, NCTXT = NB * 8 * 16;
    int hcur = -1;
    for (int t0 = gw * 8; t0 < NLAT + NCTXT * 8; t0 += NW * 8) {
#pragma unroll 1
        for (int ti8 = 0; ti8 < 8; ++ti8) { const int task = t0 + ti8;
            int b, h, qrow0; bool lat; int rq = 0, j = 0;
            if (task < NLAT) { lat = true; j = task & 3; rq = (task >> 2) & 127; h = (task >> 9) & 7; b = task >> 12; qrow0 = b * TL + rq * 64 + 16 * j; }
            else { const int tc = task - NLAT; if ((tc & 7) != 0 || (tc >> 3) >= NCTXT) continue; const int t2 = tc >> 3; lat = false; const int qt = t2 & 15; h = (t2 >> 4) & 7; b = t2 >> 7; qrow0 = MLAT + b * LC + 16 * qt; }
            if (h != hcur) { for (int i = lane; i < 465; i += 64) rpbl[i] = rpb[h * 465 + i]; hcur = h; }
            bf16x8_t Qf[2];
            { const bf16_t* qp = p0 + (size_t)(qrow0 + fr) * NIN0 + 1792 + h * 64 + 8 * fq; Qf[0] = *(const bf16x8_t*)qp; Qf[1] = *(const bf16x8_t*)(qp + 32); }
            f32x4 O[4];
#pragma unroll
            for (int dt = 0; dt < 4; ++dt) O[dt] = (f32x4){0.f, 0.f, 0.f, 0.f};
            float m_run = -1e30f, l_run = 0.f;
            const int bh = b * 8 + h;
            if (lat) { const int r0 = min(max(rq - 4, 0), 120); const int cs = (j == 0) ? 0 : (j == 1 ? 8 : (j == 2 ? 24 : 32));
                na_block<true>(p0, vtl, rpbl, Qf, O, m_run, l_run, b * TL + r0 * 64 + cs, h, (size_t)bh * 64 * TL + (size_t)r0 * 64 + cs, TL, rq - r0, 16 * j + fr, cs, fr, fq); }
            na_block<false>(p0, vtc, rpbl, Qf, O, m_run, l_run, MLAT + b * LC, h, (size_t)bh * 64 * LC, LC, 0, 0, 0, fr, fq);
            const float inv = frcp(l_run);
#pragma unroll
            for (int dt = 0; dt < 4; ++dt) { const f32x4 o = O[dt] * inv; *(u32x2*)(mix + (size_t)(qrow0 + fr) * DM + 512 + h * 64 + 16 * dt + 4 * fq) = pack4(o); }
        }
    }
}


__device__ __forceinline__ void ph_adaln(const MP& p, int bid, int nblk, char* lds) {
    const float* c = p.in[1]; const float* c_ctx = p.in[3]; const float* ada_w = p.in[6]; const float* ada_b = p.in[7]; const float* hg_lower = p.in[27];
    float* mod = (float*)(p.ws + WS_MOD); float* lb = (float*)(p.ws + WS_LB);
    float* s = (float*)lds; float* red = s + 5 * 1024;
    const int tid = threadIdx.x;
    __syncthreads();
    for (int i = tid; i < 5 * 1024; i += 512) { const int mb = i >> 10, k = i & 1023; const float x = mb < 4 ? c[mb * 1024 + k] : c_ctx[k]; s[i] = siluf_(x); }
    __syncthreads();
    for (int it = bid; it < 2 * 96; it += nblk) { const int l = it / 96, n0 = (it % 96) * 64;
        gemv5_item(ada_w + (size_t)l * 1024 * 6144, 6144, n0, s, red, mod + (size_t)l * 5 * 6144, 6144, ada_b + l * 6144); }
    if (bid == nblk - 1) for (int k = tid; k < 1024; k += 512) lb[k] = sigmoidf_(hg_lower[1024 + k] - hg_lower[k]);
    __syncthreads();
}
__device__ __forceinline__ void ph_wt(const MP& p, int bid, int nblk, char* lds) {
    const float* w_in0 = p.in[10]; const float* w_out0 = p.in[11]; const float* w1 = p.in[8]; const float* w2 = p.in[9]; const float* w_in1 = p.in[25]; const float* w_out1 = p.in[26];
    char* wt = p.ws + WS_WT;
    const int tid = threadIdx.x, w = tid >> 6, lane = tid & 63;
    float* scr = (float*)lds + w * 64 * 33;
    const int gw = bid * 8 + w, NGW = nblk * 8;
    __syncthreads();
#define WT_JOB(Wp, K_, N_, off_) { const int nitems = ((K_) / 64) * ((N_) / 32); for (int it = gw; it < nitems; it += NGW) transpose_item((Wp), (K_), (N_), (bf16_t*)(wt + (off_)), scr, it, lane); }
    WT_JOB(w_in0, 1024, NIN0, WT_IN0) WT_JOB(w_out0, 1024, 1024, WT_OUT0) WT_JOB(w1, 1024, NHID, WT_W10) WT_JOB(w2, NHID, 1024, WT_W20)
    WT_JOB(w_in1, 1024, NIN1, WT_IN1) WT_JOB(w_out1, 1024, 1024, WT_OUT1) WT_JOB(w1 + (size_t)1024 * NHID, 1024, NHID, WT_W11) WT_JOB(w2 + (size_t)NHID * 1024, NHID, 1024, WT_W21)
#undef WT_JOB
    __syncthreads();
}
__device__ __forceinline__ void ph_gs(const MP& p, int bid, int nblk) {
    const float* mod = (const float*)(p.ws + WS_MOD); const float* norm_mix_g = p.in[4]; const float* norm_mlp_g = p.in[5]; float* gs = (float*)(p.ws + WS_GS);
    for (int i = bid * 512 + threadIdx.x; i < 4 * 5 * 1024; i += nblk * 512) {
        const int w = i / 5120, mb = (i / 1024) % 5, k = i & 1023, l = w >> 1, second = w & 1;
        const float g = second ? norm_mlp_g[l * 1024 + k] : norm_mix_g[l * 1024 + k];
        const float sc = mod[(size_t)(l * 5 + mb) * 6144 + (second ? 4 * 1024 : 1024) + k];
        gs[i] = g * (1.f + sc); }
}
__device__ __forceinline__ void ph_shw(const MP& p, int bid, int nblk, char* lds) {
    const float* mod = (const float*)(p.ws + WS_MOD); const float* w_in0 = p.in[10]; const float* w1 = p.in[8]; const float* w_in1 = p.in[25];
    float* s = (float*)lds; float* red = s + 5 * 1024;
    const int tid = threadIdx.x;
    int cur = -1;
    for (int it = bid; it < 52 + 64 + 80 + 64; it += nblk) {
        int which, n0; const float* W; int ldw; float* out;
        if (it < 52) { which = 0; n0 = it * 64; W = w_in0; ldw = NIN0; out = (float*)(p.ws + WS_SHW0); }
        else if (it < 116) { which = 1; n0 = (it - 52) * 64; W = w1; ldw = NHID; out = (float*)(p.ws + WS_SHW1); }
        else if (it < 196) { which = 2; n0 = (it - 116) * 64; W = w_in1; ldw = NIN1; out = (float*)(p.ws + WS_SHW2); }
        else { which = 3; n0 = (it - 196) * 64; W = w1 + (size_t)1024 * NHID; ldw = NHID; out = (float*)(p.ws + WS_SHW3); }
        if (which != cur) { __syncthreads(); const int l = which >> 1, off = (which & 1) ? 3 * 1024 : 0;
            for (int i = tid; i < 5 * 1024; i += 512) { const int mb = i >> 10, k = i & 1023; s[i] = mod[(size_t)(l * 5 + mb) * 6144 + off + k]; }
            __syncthreads(); cur = which; }
        gemv5_item(W, ldw, n0, s, red, out, ldw, nullptr);
    }
    __syncthreads();
}
__device__ __forceinline__ void ph_norm_in(const MP& p, int bid, int nblk) {
    const float* x = p.in[0]; const float* ctx = p.in[2]; const float* ng = p.in[4]; const float* mod = (const float*)(p.ws + WS_MOD);
    bf16_t* xb = (bf16_t*)(p.ws + WS_BUF0); float* ssq = (float*)(p.ws + WS_SSQ);
    const int w = threadIdx.x >> 6, lane = threadIdx.x & 63;
    for (int row = bid * 8 + w; row < MALL; row += nblk * 8) {
        const float* xr = row < MLAT ? x + (size_t)row * DM : ctx + (size_t)(row - MLAT) * DM;
        const int mb = row < MLAT ? row >> 13 : 4;
        const f32x4* x4 = (const f32x4*)xr + lane; const f32x4* g4 = (const f32x4*)ng + lane; const f32x4* s4 = (const f32x4*)(mod + (size_t)mb * 6144 + 1024) + lane;
        f32x4 v[4]; float s = 0.f;
#pragma unroll
        for (int j = 0; j < 4; ++j) { v[j] = x4[64 * j]; s += (v[j].x * v[j].x + v[j].y * v[j].y) + (v[j].z * v[j].z + v[j].w * v[j].w); }
        s = wave_sum(s);
        u32x2* o = (u32x2*)(xb + (size_t)row * DM) + lane;
#pragma unroll
        for (int j = 0; j < 4; ++j) { const f32x4 g = g4[64 * j] * (s4[64 * j] + 1.f); u32x2 pk; pk.x = pk2(v[j].x * g.x, v[j].y * g.y); pk.y = pk2(v[j].z * g.z, v[j].w * g.w); o[64 * j] = pk; }
        if (lane < 16) ssq[(size_t)row * 16 + lane] = lane == 0 ? s : 0.f;
    }
}
__device__ __forceinline__ void ph_final(const MP& p, int bid, int nblk) {
    float* out = p.out; const float* ssq = (const float*)(p.ws + WS_SSQ); const float* g = p.in[29];
    const int w = threadIdx.x >> 6, lane = threadIdx.x & 63;
    for (int row = bid * 8 + w; row < MLAT; row += nblk * 8) {
        float s = lane < 16 ? ssq[(size_t)row * 16 + lane] : 0.f; s = wave_sum(s);
        const float rstd = rsqrtf(s * (1.f / 1024.f) + NORM_EPS);
        f32x4* o4 = (f32x4*)(out + (size_t)row * DM) + lane; const f32x4* g4 = (const f32x4*)g + lane;
#pragma unroll
        for (int j = 0; j < 4; ++j) { f32x4 v = o4[64 * j]; const f32x4 gg = g4[64 * j]; v = v * rstd * gg; o4[64 * j] = v; }
    }
}

__device__ __forceinline__ RwkvW mk_rwkvw(const MP& p) {
    RwkvW W; W.mu_prev = p.in[12]; W.mu_next = p.in[13]; W.w0 = p.in[14]; W.w_up = p.in[15]; W.a0 = p.in[16]; W.a_up = p.in[17]; W.g_up = p.in[18]; W.k_k = p.in[19]; W.k_a = p.in[20]; W.r_k = p.in[21]; W.ln_g = p.in[22]; W.ln_b = p.in[23]; return W; }
__device__ __forceinline__ RwkvTmp mk_rwkvtmp(const MP& p) {
    const size_t RH = (size_t)2 * (TL + LC), AB = RH * 512 * 2, AF = RH * 512 * 4;
    char* t0 = (char*)p.out; char* t1 = p.ws + WS_BIG + BIG_P0END;
    RwkvTmp T; T.lw0 = (float*)t0; T.lw1 = (float*)(t0 + AF); T.osum = (float*)(t0 + 2 * AF); T.r = (bf16_t*)(t0 + 3 * AF);
    T.k = (bf16_t*)t1; T.v = (bf16_t*)(t1 + AB); T.kk = (bf16_t*)(t1 + 2 * AB); T.a0 = (bf16_t*)(t1 + 3 * AB); T.a1 = (bf16_t*)(t1 + 4 * AB); T.g = (bf16_t*)(t1 + 5 * AB); return T; }
constexpr int PREP_TOK = 8;
__device__ __forceinline__ void ph_rwkv_prep(const MP& p, int bid, int nblk, char* lds, int b0) {
    const int nbh = 2; const bf16_t* p0 = (const bf16_t*)(p.ws + WS_BIG); const RwkvW W = mk_rwkvw(p); const RwkvTmp T = mk_rwkvtmp(p); float* bc = (float*)(p.ws + WS_BC);
    float (*lin)[256] = (float (*)[256])lds;
    const int tid = threadIdx.x, lane = tid & 63;
    const int nrows = nbh * (TL + LC);
    { f32x4* z = (f32x4*)T.osum; const size_t n4 = (size_t)nrows * 512 / 4; for (size_t i = (size_t)bid * 512 + tid; i < n4; i += (size_t)nblk * 512) z[i] = (f32x4){0.f, 0.f, 0.f, 0.f}; }
    for (int base = bid * PREP_TOK; base < nrows; base += nblk * PREP_TOK) {
        __syncthreads();
        if (tid < 256) { const int col = 1536 + tid; const float mup = W.mu_prev[col], mun = W.mu_next[col];
#pragma unroll
            for (int tk = 0; tk < PREP_TOK; ++tk) { int grow, t, slen; lrow_info(base + tk, b0, nbh, grow, t, slen);
                const float x = shifted(p0, grow, t, slen, col, mup, mun);
                lin[tk][tid] = tid < 64 ? tanhf(x) : (tid < 128 ? x : sigmoidf_(x)); } }
        __syncthreads();
        { const int c = tid;
            float wl0[PREP_TOK], wl1[PREP_TOK], av0[PREP_TOK], av1[PREP_TOK], gv[PREP_TOK];
#pragma unroll
            for (int tk = 0; tk < PREP_TOK; ++tk) { wl0[tk] = W.w0[c]; wl1[tk] = W.w0[512 + c]; av0[tk] = W.a0[c]; av1[tk] = W.a0[512 + c]; gv[tk] = 0.f; }
#pragma unroll 4
            for (int j = 0; j < 64; ++j) { const float u0 = W.w_up[(size_t)j * 512 + c], u1 = W.w_up[(size_t)(64 + j) * 512 + c], q0 = W.a_up[(size_t)j * 512 + c], q1 = W.a_up[(size_t)(64 + j) * 512 + c];
#pragma unroll
                for (int tk = 0; tk < PREP_TOK; ++tk) { const float tl = lin[tk][j], al = lin[tk][64 + j]; wl0[tk] += tl * u0; wl1[tk] += tl * u1; av0[tk] += al * q0; av1[tk] += al * q1; } }
#pragma unroll 4
            for (int j = 0; j < 128; ++j) { const float gu = W.g_up[(size_t)j * 512 + c];
#pragma unroll
                for (int tk = 0; tk < PREP_TOK; ++tk) gv[tk] += lin[tk][128 + j] * gu; }
            const float mpr = W.mu_prev[c], mnr = W.mu_next[c], mpk = W.mu_prev[512 + c], mnk = W.mu_next[512 + c], mpv = W.mu_prev[1024 + c], mnv = W.mu_next[1024 + c];
            const float kkc = W.k_k[c], kac = W.k_a[c], rkc = W.r_k[c];
#pragma unroll
            for (int tk = 0; tk < PREP_TOK; ++tk) { int grow, t, slen; lrow_info(base + tk, b0, nbh, grow, t, slen);
                const float r = shifted(p0, grow, t, slen, c, mpr, mnr), k = shifted(p0, grow, t, slen, 512 + c, mpk, mnk), v = shifted(p0, grow, t, slen, 1024 + c, mpv, mnv);
                const float sp0 = wl0[tk] > 15.f ? 0.f : log1pf(__expf(-wl0[tk])), sp1 = wl1[tk] > 15.f ? 0.f : log1pf(__expf(-wl1[tk]));
                const float lw0 = -__expf(-(wl0[tk] < -15.f ? -wl0[tk] : sp0) - 0.5f), lw1 = -__expf(-(wl1[tk] < -15.f ? -wl1[tk] : sp1) - 0.5f);
                const float a0 = sigmoidf_(av0[tk]), a1 = sigmoidf_(av1[tk]);
                float kk = k * kkc; const float n2 = wave_sum(kk * kk); kk = kk / fmaxf(sqrtf(n2), 1e-12f);
                const float kd0 = k * (1.f + (a0 - 1.f) * kac), kd1 = k * (1.f + (a1 - 1.f) * kac);
                const float bsum = wave_sum(r * rkc * (kd0 + kd1));
                const size_t o = (size_t)(base + tk) * 512 + c;
                T.r[o] = f2bf(r); T.k[o] = f2bf(k); T.v[o] = f2bf(v); T.kk[o] = f2bf(kk); T.a0[o] = f2bf(a0); T.a1[o] = f2bf(a1); T.g[o] = f2bf(gv[tk]); T.lw0[o] = lw0; T.lw1[o] = lw1;
                if (lane == 0) bc[(size_t)grow * 8 + (c >> 6)] = bsum; }
        }
    }
    __syncthreads();
}
__device__ __forceinline__ void ph_rwkv_scan(const MP& p, int bid) {
    const int nbh = 2; const RwkvTmp T = mk_rwkvtmp(p); const float* k_a = p.in[20];
    const int chain = bid * 2 + (threadIdx.x >> 8), dir = chain / (nbh * 8), lb = (chain / 8) % nbh, h = chain & 7;
    const int tid = threadIdx.x & 255, v = tid >> 2, kq = tid & 3;
    float S[16], ka[16];
#pragma unroll
    for (int i = 0; i < 16; ++i) { S[i] = 0.f; ka[i] = k_a[h * 64 + kq * 16 + i]; }
    const int nsteps = LC + TL;
    auto lrow_of = [&](int s) -> size_t { if (s < LC) { const int t = dir ? LC - 1 - s : s; return (size_t)nbh * TL + lb * LC + t; } const int s2 = s - LC; const int t = dir ? TL - 1 - s2 : s2; return (size_t)lb * TL + t; };
    ScanIn cur, nxt; scan_load(cur, T, dir, lrow_of(0), h, v, kq);
    for (int s = 0; s < nsteps; ++s) {
        const size_t lrow = lrow_of(s);
        if (s + 1 < nsteps) scan_load(nxt, T, dir, lrow_of(s + 1), h, v, kq); else nxt = cur;
        float r[16], k[16], kk[16], a[16], w[16];
#pragma unroll
        for (int i = 0; i < 16; ++i) { const int q = i >> 3, j = (i >> 1) & 3, hi = i & 1; r[i] = bfu(cur.r[q][j], hi); k[i] = bfu(cur.k[q][j], hi); kk[i] = bfu(cur.kk[q][j], hi); a[i] = bfu(cur.a[q][j], hi); w[i] = __expf(cur.lw[i >> 2][i & 3]); }
        float skk = 0.f;
#pragma unroll
        for (int i = 0; i < 16; ++i) skk += S[i] * kk[i];
        skk += __shfl_xor(skk, 1); skk += __shfl_xor(skk, 2);
        float o = 0.f;
#pragma unroll
        for (int i = 0; i < 16; ++i) { const float kd = k[i] * (1.f + (a[i] - 1.f) * ka[i]); S[i] = S[i] * w[i] - skk * (kk[i] * a[i]) + cur.v * kd; o += S[i] * r[i]; }
        o += __shfl_xor(o, 1); o += __shfl_xor(o, 2);
        if (kq == 0) atomicAdd(T.osum + lrow * 512 + h * 64 + v, o);
        cur = nxt;
    }
}
__device__ __forceinline__ void ph_rwkv_post(const MP& p, int bid, int nblk, int b0) {
    const int nbh = 2; const RwkvTmp T = mk_rwkvtmp(p); const float* bc = (const float*)(p.ws + WS_BC); const float* ln_g = p.in[22]; const float* ln_b = p.in[23]; bf16_t* mix = (bf16_t*)(p.ws + WS_BUF0);
    const int w = threadIdx.x >> 6, lane = threadIdx.x & 63; const int nrows = nbh * (TL + LC);
    for (int lr = bid * 8 + w; lr < nrows; lr += nblk * 8) { int grow, t, slen; lrow_info(lr, b0, nbh, grow, t, slen);
        const float* op = T.osum + (size_t)lr * 512 + lane * 8; float o[8]; float s = 0.f;
#pragma unroll
        for (int i = 0; i < 8; ++i) { o[i] = op[i]; s += o[i]; }
        s += __shfl_xor(s, 1); s += __shfl_xor(s, 2); s += __shfl_xor(s, 4); const float mu = s * (1.f / 64.f); float q = 0.f;
#pragma unroll
        for (int i = 0; i < 8; ++i) { const float d = o[i] - mu; q += d * d; }
        q += __shfl_xor(q, 1); q += __shfl_xor(q, 2); q += __shfl_xor(q, 4); const float rs = rsqrtf(q * (1.f / 64.f) + 64e-5f);
        const float bcv = bc[(size_t)grow * 8 + (lane >> 3)]; unsigned pk[4];
#pragma unroll
        for (int i = 0; i < 8; i += 2) { float y[2];
#pragma unroll
            for (int e = 0; e < 2; ++e) { const int c = lane * 8 + i + e; const float vv = bf2f(T.v[(size_t)lr * 512 + c]), gg = bf2f(T.g[(size_t)lr * 512 + c]);
                y[e] = ((o[i + e] - mu) * rs * ln_g[c] + ln_b[c] + bcv * vv) * gg; }
            pk[i >> 1] = pk2(y[0], y[1]); }
        u32x4 st; st.x = pk[0]; st.y = pk[1]; st.z = pk[2]; st.w = pk[3];
        *(u32x4*)(mix + (size_t)grow * DM + lane * 8) = st;
    }
}

__device__ __forceinline__ void ph_na(const MP& p, int bid, int nblk, char* lds, int t_lo, int t_hi) {
    const bf16_t* p0 = (const bf16_t*)(p.ws + WS_BIG); const float* rpb = p.in[24]; bf16_t* mix = (bf16_t*)(p.ws + WS_BUF0);
    float (*pbuf)[384] = (float (*)[384])lds;
    const int w = threadIdx.x >> 6, lane = threadIdx.x & 63;
    for (int task = t_lo + bid * 8 + w; task < t_hi; task += nblk * 8) {
        const int grow = task >> 3, h = task & 7;
        const bool lat = grow < MLAT;
        const int b = lat ? grow >> 13 : (grow - MLAT) >> 8;
        const int tq = lat ? grow & 8191 : 0, rq = tq >> 6, cq = tq & 63;
        const int r0 = min(max(rq - 4, 0), 120), c0 = min(max(cq - 8, 0), 48);
        const int nkeys = lat ? 384 : 256;
        float q[64];
        { const u32x4* qp = (const u32x4*)(p0 + (size_t)grow * NIN0 + 1792 + h * 64);
#pragma unroll
          for (int i = 0; i < 8; ++i) { const u32x4 x = qp[i];
#pragma unroll
              for (int j = 0; j < 4; ++j) { q[i * 8 + 2 * j] = bfu(x[j], 0); q[i * 8 + 2 * j + 1] = bfu(x[j], 1); } } }
        float sc[6]; float mx = -1e30f;
#pragma unroll
        for (int jj = 0; jj < 6; ++jj) { const int j = jj * 64 + lane; sc[jj] = -1e30f;
            if (j < nkeys) { int krow; float bias = 0.f;
                if (lat && j < 128) { const int kr = j >> 4, kc = j & 15; krow = b * TL + (r0 + kr) * 64 + c0 + kc; bias = rpb[(h * 15 + (r0 + kr - rq + 7)) * 31 + (c0 + kc - cq + 15)]; }
                else { const int l = lat ? j - 128 : j; krow = MLAT + b * LC + l; }
                const u32x4* kp = (const u32x4*)(p0 + (size_t)krow * NIN0 + 2304 + h * 64); float d = 0.f;
#pragma unroll
                for (int i = 0; i < 8; ++i) { const u32x4 x = kp[i];
#pragma unroll
                    for (int jx = 0; jx < 4; ++jx) d += q[i * 8 + 2 * jx] * bfu(x[jx], 0) + q[i * 8 + 2 * jx + 1] * bfu(x[jx], 1); }
                sc[jj] = d * 0.125f + bias; }
            mx = fmaxf(mx, sc[jj]); }
#pragma unroll
        for (int o = 1; o < 64; o <<= 1) mx = fmaxf(mx, __shfl_xor(mx, o));
        float sum = 0.f;
#pragma unroll
        for (int jj = 0; jj < 6; ++jj) { const int j = jj * 64 + lane; const float pv = j < nkeys ? __expf(sc[jj] - mx) : 0.f; sum += pv; if (j < 384) pbuf[w][j] = pv; }
        sum = wave_sum(sum);
        __builtin_amdgcn_s_waitcnt(0xc07f); asm volatile("" ::: "memory");
        float acc = 0.f;
        for (int j = 0; j < nkeys; ++j) { int krow;
            if (lat && j < 128) { const int kr = j >> 4, kc = j & 15; krow = b * TL + (r0 + kr) * 64 + c0 + kc; }
            else { const int l = lat ? j - 128 : j; krow = MLAT + b * LC + l; }
            acc += pbuf[w][j] * bf2f(p0[(size_t)krow * NIN0 + 2816 + h * 64 + lane]); }
        mix[(size_t)grow * DM + 512 + h * 64 + lane] = f2bf(acc / sum);
        __builtin_amdgcn_s_waitcnt(0xc07f); asm volatile("" ::: "memory");
    }
}

__device__ __forceinline__ void ph_hgrn_scan(const MP& p, int bid, int dir) {
    const bf16_t* p1 = (const bf16_t*)(p.ws + WS_BIG); const float* lbv = (const float*)(p.ws + WS_LB); bf16_t* obuf = (bf16_t*)(p.ws + WS_BUF0);
    const int b = bid >> 3, h = bid & 7; const int tid = threadIdx.x, v = tid >> 2, kq = tid & 3;
    float S[32], lb[32];
#pragma unroll
    for (int i = 0; i < 32; ++i) { S[i] = 0.f; lb[i] = lbv[h * 128 + kq * 32 + i]; }
    const int nsteps = LC + TL; const int fcol = (dir ? 2048 : 1024) + h * 128 + kq * 32, qcol = h * 128 + kq * 32, icol = 3072 + h * 128 + v;
    auto grow_of = [&](int s) -> size_t { if (s < LC) { const int t = dir ? LC - 1 - s : s; return (size_t)MLAT + b * LC + t; } const int s2 = s - LC; const int t = dir ? TL - 1 - s2 : s2; return (size_t)b * TL + t; };
    u32x4 fq_[4], qq_[4], nf_[4], nq_[4]; float iv, niv;
    { const size_t g0 = grow_of(0); const u32x4* fp = (const u32x4*)(p1 + g0 * NIN1 + fcol); const u32x4* qp = (const u32x4*)(p1 + g0 * NIN1 + qcol);
#pragma unroll
      for (int i = 0; i < 4; ++i) { fq_[i] = fp[i]; qq_[i] = qp[i]; nf_[i] = fp[i]; nq_[i] = qp[i]; } iv = bf2f(p1[g0 * NIN1 + icol]); niv = iv; }
    for (int s = 0; s < nsteps; ++s) {
        const size_t grow = grow_of(s);
        if (s + 1 < nsteps) { const size_t g1 = grow_of(s + 1); const u32x4* fp = (const u32x4*)(p1 + g1 * NIN1 + fcol); const u32x4* qp = (const u32x4*)(p1 + g1 * NIN1 + qcol);
#pragma unroll
            for (int i = 0; i < 4; ++i) { nf_[i] = fp[i]; nq_[i] = qp[i]; } niv = bf2f(p1[g1 * NIN1 + icol]); }
        float o = 0.f;
#pragma unroll
        for (int i = 0; i < 32; ++i) { const float f = bfu(fq_[i >> 3][(i >> 1) & 3], i & 1), qv = bfu(qq_[i >> 3][(i >> 1) & 3], i & 1);
            const float fg = lb[i] + (1.f - lb[i]) * sigmoidf_(f); S[i] = fg * S[i] + (1.f - fg) * iv; o += S[i] * qv; }
        o += __shfl_xor(o, 1); o += __shfl_xor(o, 2);
        if (kq == 0 && s >= LC) { bf16_t* op = obuf + grow * DM + h * 128 + v; *op = dir ? f2bf(o + bf2f(*op)) : f2bf(o); }
#pragma unroll
        for (int i = 0; i < 4; ++i) { fq_[i] = nf_[i]; qq_[i] = nq_[i]; } iv = niv;
    }
}
__device__ __forceinline__ void ph_hgrn_out(const MP& p, int bid, int nblk) {
    bf16_t* obuf = (bf16_t*)(p.ws + WS_BUF0); const bf16_t* p1 = (const bf16_t*)(p.ws + WS_BIG); const float* g = p.in[28];
    const int w = threadIdx.x >> 6, lane = threadIdx.x & 63;
    for (int row = bid * 8 + w; row < MLAT; row += nblk * 8) {
        bf16_t* op = obuf + (size_t)row * DM + lane * 16; const bf16_t* gp = p1 + (size_t)row * NIN1 + 4096 + lane * 16;
        float o[16]; float s = 0.f;
#pragma unroll
        for (int i = 0; i < 16; ++i) { o[i] = bf2f(op[i]); s += o[i] * o[i]; }
        s = wave_sum(s); const float rs = rsqrtf(s * (1.f / 1024.f) + NORM_EPS);
#pragma unroll
        for (int i = 0; i < 16; ++i) op[i] = f2bf(o[i] * rs * g[lane * 16 + i] * siluf_(bf2f(gp[i])));
    }
}

template <int ACT> __device__ __forceinline__ void ph_gemm_act(LAS unsigned char* lds, const bf16_t* A, const bf16_t* Bt, int M, int N, int K, bf16_t* O, const float* ssq, const float* shw, int G, int bid, bf16_t* vtl = nullptr, bf16_t* vtc = nullptr) {
    pg8::Gemm g; g.A = A; g.Bt = Bt; g.M = M; g.N = N; g.K = K; pg8::StaticOrder S; S.init(M, N, G, bid);
    pg8::EpiAct<ACT> E; E.O = O; E.ldc = N; E.ssq = ssq; E.shw = shw; E.ncol = N; E.vtl = vtl; E.vtc = vtc;
    pg8::gemm_phase<pg8::EpiAct<ACT>, pg8::StaticOrder, true, true>(lds, g, S, E);
}
template <bool HB> __device__ __forceinline__ void ph_gemm_res(LAS unsigned char* lds, const bf16_t* A, const bf16_t* Bt, int M, int K, const float* hin_lat, const float* hin_ctx, float* hout_lat, float* hout_ctx,
                                                              const float* gate, const float* gsn, bf16_t* hb, float* ssq, int G, int bid) {
    pg8::Gemm g; g.A = A; g.Bt = Bt; g.M = M; g.N = DM; g.K = K; pg8::StaticOrder S; S.init(M, DM, G, bid);
    pg8::EpiRes<HB> E; E.hin_lat = hin_lat; E.hin_ctx = hin_ctx; E.hout_lat = hout_lat; E.hout_ctx = hout_ctx; E.gate = gate; E.gsn = gsn; E.hb = hb; E.ssq = ssq;
    pg8::gemm_phase<pg8::EpiRes<HB>, pg8::StaticOrder, true, true>(lds, g, S, E);
}

constexpr int NPHASE = 20;
__global__ void __launch_bounds__(NTHREADS, 2) mega(MP p) {
    extern __shared__ __attribute__((aligned(16))) unsigned char lds_raw[];
    LAS unsigned char* lds = (LAS unsigned char*)lds_raw;
    char* ldsg = (char*)lds_raw;
    const int tid = threadIdx.x;
    const int G = gridDim.x, bid = blockIdx.x;
    volatile LAS unsigned* MISC = (volatile LAS unsigned*)(lds + MISC_OFF);
    for (int u = tid; u < (LDS_BYTES - LDSCTL_OFF) / 4; u += NTHREADS) ((LAS unsigned*)(lds + LDSCTL_OFF))[u] = 0u;
    __syncthreads();
    unsigned* ctl = (unsigned*)(p.ws + WS_CTL);
    const bool multi = (p.ph_hi - p.ph_lo) > 1;
    XcdBarrier bar; bar.bar = ctl + CW_BAR; bar.x = 0; bar.st = nullptr;
    if (multi) bar = xcd_barrier_post(ctl + CW_BAR, MISC + 8);
    const int lo = p.ph_lo, hi = p.ph_hi;
#define IN(k) (lo <= (k) && (k) < hi)
#ifndef MK_DUP
#define MK_DUP -1
#endif
#define DUP(k) (IN(k) && MK_DUP == (k))
#define SEAM(k) do { if (IN(k) && IN((k) + 1)) xcd_barrier(bar); } while (0)
    char* ws = p.ws; float* out = p.out;
    const float* mod = (const float*)(ws + WS_MOD); const float* gs = (const float*)(ws + WS_GS); float* ssq = (float*)(ws + WS_SSQ); float* hctx = (float*)(ws + WS_HCTX);
    bf16_t* buf0 = (bf16_t*)(ws + WS_BUF0); bf16_t* big = (bf16_t*)(ws + WS_BIG); bf16_t* hbs = (bf16_t*)(ws + WS_BIG + BIG_HB);
    const float* mod1 = mod + (size_t)5 * 6144;
#define WTP(off) ((const bf16_t*)(ws + WS_WT + (off)))
    constexpr int NA_TASKS = MALL * 8, NA_HALF = NA_TASKS / 2;

    if (IN(0)) { ph_adaln(p, bid, G, ldsg); ph_wt(p, bid, G, ldsg); ph_lora_w(p, bid, G); } SEAM(0);
    if (IN(1)) { ph_gs(p, bid, G); ph_shw(p, bid, G, ldsg); ph_norm_in(p, bid, G); } SEAM(1);
    if (IN(2)) ph_gemm_act<3>(lds, buf0, WTP(WT_IN0), MALL, NIN0, DM, big, ssq, (const float*)(ws + WS_SHW0), G, bid, (bf16_t*)(ws + WS_VTL), (bf16_t*)(ws + WS_VTC)); if (DUP(2)) { __syncthreads(); ph_gemm_act<3>(lds, buf0, WTP(WT_IN0), MALL, NIN0, DM, big, ssq, (const float*)(ws + WS_SHW0), G, bid, (bf16_t*)(ws + WS_VTL), (bf16_t*)(ws + WS_VTC)); } SEAM(2);
    if (IN(3)) ph_lora_in(p, bid, G); SEAM(3);
    if (IN(4)) ph_rwkv<0>(p, bid, G, lds); if (DUP(4)) { __syncthreads(); ph_rwkv<0>(p, bid, G, lds); } SEAM(4);
    if (IN(5)) ph_rwkv_scan2(p, bid, G); if (DUP(5)) { __syncthreads(); ph_rwkv_scan2(p, bid, G); } SEAM(5);
    if (IN(6)) ph_rwkv<1>(p, bid, G, lds); if (DUP(6)) { __syncthreads(); ph_rwkv<1>(p, bid, G, lds); } SEAM(6);
    if (IN(7)) ph_na2(p, bid, G, lds); if (DUP(7)) { __syncthreads(); ph_na2(p, bid, G, lds); } SEAM(7);
    if (IN(9)) ph_gemm_res<true>(lds, buf0, WTP(WT_OUT0), MALL, DM, p.in[0], p.in[2], out, hctx, mod + 2 * 1024, gs + 1 * 5 * 1024, hbs, ssq, G, bid); SEAM(9);
    if (IN(10)) ph_gemm_act<1>(lds, hbs, WTP(WT_W10), MALL, NHID, DM, big, ssq, (const float*)(ws + WS_SHW1), G, bid); if (DUP(10)) { __syncthreads(); ph_gemm_act<1>(lds, hbs, WTP(WT_W10), MALL, NHID, DM, big, ssq, (const float*)(ws + WS_SHW1), G, bid); } SEAM(10);
    if (IN(11)) ph_gemm_res<true>(lds, big, WTP(WT_W20), MALL, NHID, out, hctx, out, hctx, mod + 5 * 1024, gs + 2 * 5 * 1024, buf0, ssq, G, bid); SEAM(11);
    if (IN(12)) ph_gemm_act<2>(lds, buf0, WTP(WT_IN1), MALL, NIN1, DM, big, ssq, (const float*)(ws + WS_SHW2), G, bid); if (DUP(12)) { __syncthreads(); ph_gemm_act<2>(lds, buf0, WTP(WT_IN1), MALL, NIN1, DM, big, ssq, (const float*)(ws + WS_SHW2), G, bid); } SEAM(12);
    if (IN(13)) ph_hgrn<false>(p, bid, G, lds); if (DUP(13)) { __syncthreads(); ph_hgrn<false>(p, bid, G, lds); } SEAM(13);
    if (IN(14)) ph_hgrn<true>(p, bid, G, lds); if (DUP(14)) { __syncthreads(); ph_hgrn<true>(p, bid, G, lds); } SEAM(14);
    if (IN(15)) ph_hgrn_out2(p, bid, G); SEAM(15);
    if (IN(16)) ph_gemm_res<true>(lds, buf0, WTP(WT_OUT1), MLAT, DM, out, hctx, out, hctx, mod1 + 2 * 1024, gs + 3 * 5 * 1024, hbs, ssq, G, bid); SEAM(16);
    if (IN(17)) ph_gemm_act<1>(lds, hbs, WTP(WT_W11), MLAT, NHID, DM, big, ssq, (const float*)(ws + WS_SHW3), G, bid); if (DUP(17)) { __syncthreads(); ph_gemm_act<1>(lds, hbs, WTP(WT_W11), MLAT, NHID, DM, big, ssq, (const float*)(ws + WS_SHW3), G, bid); } SEAM(17);
    if (IN(18)) ph_gemm_res<false>(lds, big, WTP(WT_W21), MLAT, NHID, out, hctx, out, hctx, mod1 + 5 * 1024, nullptr, nullptr, ssq, G, bid); SEAM(18);
    if (IN(19)) ph_final(p, bid, G);
#undef IN
#undef SEAM
#undef WTP
}

#ifndef MK_N_LAUNCHES
#define MK_N_LAUNCHES 1
#endif
extern "C" void kernel_launch(void* const* d_in, const int* in_sizes, int n_in, void* d_out, int out_size, void* d_ws, size_t ws_size, hipStream_t stream) {
    static int grid = 0;
    if (grid == 0) {
        if (n_in != 30 || ws_size < WS_END) { fprintf(stderr, "kernel_launch: bad inputs (n_in %d, ws %zu < %zu)\n", n_in, ws_size, (size_t)WS_END); grid = -1; return; }
        int dev = 0, cus = 0, per_cu = 0;
        if (hipGetDevice(&dev) != hipSuccess || hipDeviceGetAttribute(&cus, hipDeviceAttributeMultiprocessorCount, dev) != hipSuccess) { grid = -1; return; }
        if (hipFuncSetAttribute((const void*)mega, hipFuncAttributeMaxDynamicSharedMemorySize, LDS_BYTES) != hipSuccess) { fprintf(stderr, "kernel_launch: hipFuncSetAttribute failed\n"); grid = -1; return; }
        if (hipOccupancyMaxActiveBlocksPerMultiprocessor(&per_cu, (const void*)mega, NTHREADS, LDS_BYTES) != hipSuccess || per_cu < 1) { fprintf(stderr, "kernel_launch: occupancy query says %d\n", per_cu); per_cu = 1; }
        (void)hipGetLastError();
        grid = cus;
    }
    if (grid < 0) return;
    (void)hipMemsetAsync((char*)d_ws + WS_CTL, 0, CTL_ZERO_BYTES, stream);
    MP a; memset((void*)&a, 0, sizeof(a));
    for (int i = 0; i < 30; ++i) a.in[i] = (const float*)d_in[i];
    a.out = (float*)d_out; a.ws = (char*)d_ws;
#if MK_N_LAUNCHES == 1
    a.ph_lo = 0; a.ph_hi = NPHASE;
    hipLaunchKernelGGL(mega, dim3(grid), dim3(NTHREADS), LDS_BYTES, stream, a);
#else
    for (int ph = 0; ph < NPHASE; ++ph) { a.ph_lo = ph; a.ph_hi = ph + 1; hipLaunchKernelGGL(mega, dim3(grid), dim3(NTHREADS), LDS_BYTES, stream, a); }
#endif
}
```
